# Optimizing an MI355X kernel written in HIP

```python
import numpy as np
import jax
import jax.numpy as jnp
from jax import lax

D_MODEL = 2048
BATCH = 1
SEQ = 8192
DEPTH = 1
DEC_BATCH = 128
DEC_SEQ = 8
PAST_LEN = 2048
PAGE_SIZE = 128

RW_HEAD = 64
RW_HEADS = D_MODEL // RW_HEAD
RW_WIDTH = RW_HEADS * RW_HEAD
DECAY_LORA = 96
ICLR_LORA = 96
GATE_LORA = 256
LNX_EPS = 64e-5
RW_COLS = (RW_WIDTH, RW_WIDTH, RW_WIDTH, DECAY_LORA, ICLR_LORA, GATE_LORA)
SHIFT_WIDTH = sum(RW_COLS)
ATT_HEAD_DIM = 128
ATT_HEADS = D_MODEL // ATT_HEAD_DIM
KV_HEADS = 4
ATT_WIDTH = ATT_HEADS * ATT_HEAD_DIM
KV_WIDTH = KV_HEADS * ATT_HEAD_DIM
IDX_HEADS = 16
IDX_DIM = 64
TOPK_MAX = 256
Q_BLOCK = 128
DSA_COLS = (ATT_WIDTH, KV_WIDTH, KV_WIDTH, IDX_HEADS * IDX_DIM, IDX_DIM, IDX_HEADS)
DSA_WIDTH = sum(DSA_COLS)
IN_COLS = SHIFT_WIDTH + DSA_WIDTH + 2 * D_MODEL
D_FF = 11 * D_MODEL // 4
CONV_W = 3
NORM_EPS = 1e-6

kernel_name = 'rwkv7_dsa_gated_hybrid_step'


def split_cols(z, sizes):
    cuts = [int(c) for c in np.cumsum(sizes)[:-1]]
    return jnp.split(z, cuts, axis=-1)


def rms_norm(x, g):
    xf = x.astype(jnp.float32)
    y = xf * lax.rsqrt(jnp.mean(xf * xf, axis=-1, keepdims=True) + NORM_EPS)
    return (y * g.astype(jnp.float32)).astype(x.dtype)


def rwkv7_scan(S0, r, w, k, v, a, b):
    def step(S, inp):
        r_t, w_t, k_t, v_t, a_t, b_t = inp
        sa = jnp.einsum('bhvk,bhk->bhv', S, a_t)
        S = S * w_t[:, :, None, :] + sa[..., None] * b_t[:, :, None, :] + v_t[..., None] * k_t[:, :, None, :]
        return S, jnp.einsum('bhvk,bhk->bhv', S, r_t)
    xs = tuple(jnp.swapaxes(t, 0, 1) for t in (r, w, k, v, a, b))
    S, out = lax.scan(step, S0, xs)
    return jnp.swapaxes(out, 0, 1), S


def rwkv7_branch(p_rw, prev_row, S0, P):
    B, T, _ = p_rw.shape
    f32 = jnp.float32
    p_prev = jnp.concatenate([prev_row[:, None, :].astype(p_rw.dtype), p_rw[:, :-1]], axis=1)
    z = p_rw + (p_prev - p_rw) * P['shift_mu']
    r, k, v, wd, ad, gd = split_cols(z, RW_COLS)
    w_log = -jax.nn.softplus(-(P['w0'] + jnp.tanh(wd) @ P['w_decay_up']).astype(f32)) - 0.5
    decay = jnp.exp(-jnp.exp(w_log))
    a = jax.nn.sigmoid(P['a0'] + ad @ P['w_a_up'])
    g = jax.nn.sigmoid(gd) @ P['w_g_up']
    heads = lambda t: t.astype(f32).reshape(B, T, RW_HEADS, RW_HEAD)
    kk = heads(k * P['k_k'])
    kk = kk / jnp.maximum(jnp.sqrt(jnp.sum(kk * kk, axis=-1, keepdims=True)), 1e-12)
    k = k * (1 + (a - 1) * P['k_a'])
    rh, kh, vh, ah = heads(r), heads(k), heads(v), heads(a)
    out, S = rwkv7_scan(S0.astype(f32), rh, heads(decay), kh, vh, -kk, kk * ah)
    mu = jnp.mean(out, axis=-1, keepdims=True)
    var = jnp.mean(jnp.square(out - mu), axis=-1, keepdims=True)
    on = ((out - mu) * lax.rsqrt(var + LNX_EPS)).reshape(B, T, RW_WIDTH) * P['lnx_w'] + P['lnx_b']
    bonus = jnp.sum(rh * kh * P['r_k'].astype(f32), axis=-1, keepdims=True) * vh
    o = (on + bonus.reshape(B, T, RW_WIDTH)) * g
    return o.astype(p_rw.dtype), S.astype(S0.dtype), p_rw[:, -1]


def indexer_scores(qi, wi, kidx):
    dots = jnp.einsum('thd,sd->ths', qi.astype(jnp.float32), kidx.astype(jnp.float32)) * (IDX_DIM ** -0.5)
    return jnp.einsum('ths,th->ts', jax.nn.relu(dots), wi.astype(jnp.float32) * (IDX_HEADS ** -0.5))


def gathered_attention(q, k_sel, v_sel, valid):
    T = q.shape[0]
    qg = q.astype(jnp.float32).reshape(T, KV_HEADS, ATT_HEADS // KV_HEADS, ATT_HEAD_DIM)
    logits = jnp.einsum('tngd,tknd->tngk', qg, k_sel.astype(jnp.float32)) * (ATT_HEAD_DIM ** -0.5)
    logits = jnp.where(valid[:, None, None, :], logits, -jnp.inf)
    p = jax.nn.softmax(logits, axis=-1)
    o = jnp.einsum('tngk,tknd->tngd', p, v_sel.astype(jnp.float32))
    return o.reshape(T, ATT_WIDTH)


def dsa_prompt(q, k, v, qi, kidx, wi):
    B, S = q.shape[0], q.shape[1]
    topk = min(TOPK_MAX, S // 4)
    key_pos = jnp.arange(S)

    def block(i):
        start = i * Q_BLOCK
        sl = lambda t: lax.dynamic_slice_in_dim(t, start, Q_BLOCK, axis=1)
        pos = start + jnp.arange(Q_BLOCK)
        allowed = key_pos[None, :] <= pos[:, None]

        def per_seq(qb, qib, wib, kb, vb, kib):
            sc = jnp.where(allowed, indexer_scores(qib, wib, kib), -jnp.inf)
            idx = lax.top_k(sc, topk)[1]
            return gathered_attention(qb, kb[idx], vb[idx], idx <= pos[:, None])
        return jax.vmap(per_seq)(sl(q), sl(qi), sl(wi), k, v, kidx)

    out = lax.map(block, jnp.arange(S // Q_BLOCK))
    return jnp.swapaxes(out, 0, 1).reshape(B, S, ATT_WIDTH)


def dsa_sample(q, k, v, qi, kidx, wi, cache_k, cache_v, cache_kidx, page_table):
    T = q.shape[1]
    past_len = page_table.shape[1] * PAGE_SIZE
    L = past_len + T
    topk = min(TOPK_MAX, L // 4)
    pos = past_len + jnp.arange(T)
    allowed = jnp.arange(L)[None, :] <= pos[:, None]

    def per_seq(args):
        qb, kb, vb, qib, kib, wib, pages = args
        past_kidx = cache_kidx[pages].reshape(past_len, IDX_DIM)
        all_kidx = jnp.concatenate([past_kidx, kib.astype(past_kidx.dtype)], axis=0)
        sc = jnp.where(allowed, indexer_scores(qib, wib, all_kidx), -jnp.inf)
        idx = lax.top_k(sc, topk)[1]
        is_new = (idx >= past_len)[..., None, None]
        pidx = jnp.minimum(idx, past_len - 1)
        phys = pages[pidx // PAGE_SIZE]
        off = pidx % PAGE_SIZE
        nidx = jnp.clip(idx - past_len, 0, T - 1)
        k_sel = jnp.where(is_new, kb[nidx].astype(cache_k.dtype), cache_k[phys, off])
        v_sel = jnp.where(is_new, vb[nidx].astype(cache_v.dtype), cache_v[phys, off])
        return gathered_attention(qb, k_sel, v_sel, idx <= pos[:, None])

    return lax.map(per_seq, (q, k, v, qi, kidx, wi, page_table))


def layer(x, c, shift_prev, S0, conv_prev, attend, P):
    B, T, _ = x.shape
    mod = jax.nn.silu(c) @ P['w_ada'] + P['b_ada']
    sh1, sc1, g1, sh2, sc2, g2 = [m[:, None, :] for m in jnp.split(mod, 6, axis=-1)]
    h = rms_norm(x, P['norm1_g']) * (1 + sc1) + sh1
    z = h @ P['w_in']
    p_rw, z_dsa, z_gate = split_cols(z, (SHIFT_WIDTH, DSA_WIDTH, 2 * D_MODEL))
    o_rw, S_new, shift_new = rwkv7_branch(p_rw, shift_prev, S0, P)
    q, k, v, qi, ki, wi = split_cols(z_dsa, DSA_COLS)
    q = rms_norm(q.reshape(B, T, ATT_HEADS, ATT_HEAD_DIM), P['q_norm_g'])
    k = rms_norm(k.reshape(B, T, KV_HEADS, ATT_HEAD_DIM), P['k_norm_g'])
    v = v.reshape(B, T, KV_HEADS, ATT_HEAD_DIM)
    qi = qi.reshape(B, T, IDX_HEADS, IDX_DIM)
    o_att = attend(q, k, v, qi, ki, wi).astype(x.dtype)
    gate_a, gate_b = jnp.split(jax.nn.sigmoid(z_gate), 2, axis=-1)
    mixed = gate_a * (o_rw @ P['w_proj_a']) + gate_b * (o_att @ P['w_proj_b'])
    x = x + g1 * (mixed @ P['w_out'])
    h2 = rms_norm(x, P['norm2_g']) * (1 + sc2) + sh2
    u_gate, u_val = jnp.split(h2 @ P['w_ffn_up'], 2, axis=-1)
    padded = jnp.concatenate([conv_prev.astype(u_gate.dtype), u_gate], axis=1)
    acc = P['conv_b']
    for j in range(CONV_W):
        acc = acc + padded[:, j:j + T] * P['conv_w'][j]
    ffn = (jax.nn.silu(acc) * u_val) @ P['w_ffn_down']
    x = x + g2 * ffn
    return x, k, v, ki, S_new, shift_new, padded[:, padded.shape[1] - (CONV_W - 1):]


def setup_inputs(seed: int = 0) -> dict:
    key = jax.random.key(seed)
    ks = iter(jax.random.split(key, 48))
    nrm = lambda shape, s: jax.random.normal(next(ks), shape, jnp.float32) * s
    unif = lambda shape, lo, hi: jax.random.uniform(next(ks), shape, jnp.float32, lo, hi)
    Ld = (DEPTH,)
    n_pages = PAST_LEN // PAGE_SIZE
    used = DEC_BATCH * n_pages
    n_pool = used + max(1, used // 4)
    page_table = jax.random.permutation(next(ks), n_pool)[:used].reshape(DEC_BATCH, n_pages).astype(jnp.int32)
    return {
        'x_prompt': nrm((BATCH, SEQ, D_MODEL), 1.0),
        'x_sample': nrm((DEC_BATCH, DEC_SEQ, D_MODEL), 1.0),
        'c_prompt': nrm((BATCH, D_MODEL), 1.0),
        'c_sample': nrm((DEC_BATCH, D_MODEL), 1.0),
        'cache_k': nrm(Ld + (n_pool, PAGE_SIZE, KV_HEADS, ATT_HEAD_DIM), 1.0),
        'cache_v': nrm(Ld + (n_pool, PAGE_SIZE, KV_HEADS, ATT_HEAD_DIM), 1.0),
        'cache_kidx': nrm(Ld + (n_pool, PAGE_SIZE, IDX_DIM), 1.0),
        'page_table': page_table,
        'state_rwkv': nrm(Ld + (DEC_BATCH, RW_HEADS, RW_HEAD, RW_HEAD), 0.3),
        'state_shift': nrm(Ld + (DEC_BATCH, SHIFT_WIDTH), 1.0),
        'state_conv': nrm(Ld + (DEC_BATCH, CONV_W - 1, D_FF), 1.0),
        'w_ada': nrm(Ld + (D_MODEL, 6 * D_MODEL), 0.5 * D_MODEL ** -0.5),
        'b_ada': nrm(Ld + (6 * D_MODEL,), 0.01),
        'norm1_g': 1.0 + nrm(Ld + (D_MODEL,), 0.1),
        'norm2_g': 1.0 + nrm(Ld + (D_MODEL,), 0.1),
        'w_in': nrm(Ld + (D_MODEL, IN_COLS), D_MODEL ** -0.5),
        'shift_mu': unif(Ld + (SHIFT_WIDTH,), 0.0, 1.0),
        'w0': unif(Ld + (RW_WIDTH,), -5.0, -1.0),
        'w_decay_up': nrm(Ld + (DECAY_LORA, RW_WIDTH), 0.5 * DECAY_LORA ** -0.5),
        'a0': nrm(Ld + (RW_WIDTH,), 0.5),
        'w_a_up': nrm(Ld + (ICLR_LORA, RW_WIDTH), 0.5 * ICLR_LORA ** -0.5),
        'w_g_up': nrm(Ld + (GATE_LORA, RW_WIDTH), GATE_LORA ** -0.5),
        'k_k': 0.85 + nrm(Ld + (RW_WIDTH,), 0.1),
        'k_a': 1.0 + nrm(Ld + (RW_WIDTH,), 0.1),
        'r_k': nrm(Ld + (RW_HEADS, RW_HEAD), 0.1),
        'lnx_w': 1.0 + nrm(Ld + (RW_WIDTH,), 0.1),
        'lnx_b': nrm(Ld + (RW_WIDTH,), 0.01),
        'q_norm_g': 1.0 + nrm(Ld + (ATT_HEAD_DIM,), 0.1),
        'k_norm_g': 1.0 + nrm(Ld + (ATT_HEAD_DIM,), 0.1),
        'w_proj_a': nrm(Ld + (RW_WIDTH, D_MODEL), RW_WIDTH ** -0.5),
        'w_proj_b': nrm(Ld + (ATT_WIDTH, D_MODEL), ATT_WIDTH ** -0.5),
        'w_out': nrm(Ld + (D_MODEL, D_MODEL), D_MODEL ** -0.5),
        'w_ffn_up': nrm(Ld + (D_MODEL, 2 * D_FF), D_MODEL ** -0.5),
        'conv_w': nrm(Ld + (CONV_W, D_FF), CONV_W ** -0.5),
        'conv_b': nrm(Ld + (D_FF,), 0.01),
        'w_ffn_down': nrm(Ld + (D_FF, D_MODEL), D_FF ** -0.5),
    }


def reference(x_prompt, x_sample, c_prompt, c_sample, cache_k, cache_v, cache_kidx, page_table,
              state_rwkv, state_shift, state_conv, w_ada, b_ada, norm1_g, norm2_g, w_in, shift_mu,
              w0, w_decay_up, a0, w_a_up, w_g_up, k_k, k_a, r_k, lnx_w, lnx_b, q_norm_g, k_norm_g,
              w_proj_a, w_proj_b, w_out, w_ffn_up, conv_w, conv_b, w_ffn_down):
    Bp = x_prompt.shape[0]
    dt = x_prompt.dtype
    yp, ys = x_prompt, x_sample
    st_p, st_s = [], []
    for l in range(DEPTH):
        P = {'w_ada': w_ada[l], 'b_ada': b_ada[l], 'norm1_g': norm1_g[l], 'norm2_g': norm2_g[l],
             'w_in': w_in[l], 'shift_mu': shift_mu[l], 'w0': w0[l], 'w_decay_up': w_decay_up[l],
             'a0': a0[l], 'w_a_up': w_a_up[l], 'w_g_up': w_g_up[l], 'k_k': k_k[l], 'k_a': k_a[l],
             'r_k': r_k[l], 'lnx_w': lnx_w[l], 'lnx_b': lnx_b[l], 'q_norm_g': q_norm_g[l],
             'k_norm_g': k_norm_g[l], 'w_proj_a': w_proj_a[l], 'w_proj_b': w_proj_b[l], 'w_out': w_out[l],
             'w_ffn_up': w_ffn_up[l], 'conv_w': conv_w[l], 'conv_b': conv_b[l], 'w_ffn_down': w_ffn_down[l]}
        yp, *sp = layer(yp, c_prompt,
                        jnp.zeros((Bp, SHIFT_WIDTH), dt),
                        jnp.zeros((Bp, RW_HEADS, RW_HEAD, RW_HEAD), jnp.float32),
                        jnp.zeros((Bp, CONV_W - 1, D_FF), dt),
                        dsa_prompt, P)
        attend_s = lambda q, k, v, qi, ki, wi, l=l: dsa_sample(q, k, v, qi, ki, wi, cache_k[l], cache_v[l],
                                                              cache_kidx[l], page_table)
        ys, *ss = layer(ys, c_sample, state_shift[l], state_rwkv[l], state_conv[l], attend_s, P)
        st_p.append(sp)
        st_s.append(ss)
    stk = lambda sts, i: jnp.stack([s[i] for s in sts], axis=0)
    return (yp, ys,
            stk(st_p, 0), stk(st_p, 1), stk(st_p, 2), stk(st_p, 3), stk(st_p, 4), stk(st_p, 5),
            stk(st_s, 0), stk(st_s, 1), stk(st_s, 2), stk(st_s, 3), stk(st_s, 4), stk(st_s, 5))
```

```cpp
#include <hip/hip_runtime.h>
#include <cstdio>
#include <cstdint>

#define LAS __attribute__((address_space(3)))
typedef unsigned short bf16_t;
typedef short bf16x8 __attribute__((ext_vector_type(8)));
typedef float f32x4 __attribute__((ext_vector_type(4)));
typedef float f32x2 __attribute__((ext_vector_type(2)));
typedef unsigned u32x4 __attribute__((ext_vector_type(4)));
typedef unsigned u32x2 __attribute__((ext_vector_type(2)));

constexpr int DM = 2048, SEQ = 8192, DEC_B = 128, DEC_T = 8, NTOK = SEQ + DEC_B * DEC_T;
constexpr int SHIFT_W = 6592, IN_COLS = 14864, ZLD = 15104;
constexpr int C_R = 0, C_K = 2048, C_V = 4096, C_WD = 6144, C_AD = 6240, C_GD = 6336;
constexpr int C_Q = 6592, C_KK = 8640, C_VV = 9152, C_QI = 9664, C_KI = 10688, C_WI = 10752, C_GA = 10768, C_GB = 12816;
constexpr int DFF = 5632, UPN = 11264, MODLD = 12288;
constexpr int NPAGES = 16, PAGE = 128, PAST = 2048;
constexpr int CHUNK = 64, NCHUNK = SEQ / CHUNK;

constexpr size_t O_YP = 0, O_YS = O_YP + (size_t)SEQ * DM, O_KP = O_YS + (size_t)1024 * DM, O_VP = O_KP + (size_t)SEQ * 512, O_KIP = O_VP + (size_t)SEQ * 512,
                 O_RWP = O_KIP + (size_t)SEQ * 64, O_SHP = O_RWP + 32 * 64 * 64, O_CVP = O_SHP + SHIFT_W, O_KS = O_CVP + 2 * DFF, O_VS = O_KS + 1024 * 512,
                 O_KIS = O_VS + 1024 * 512, O_RWS = O_KIS + 1024 * 64, O_SHS = O_RWS + (size_t)DEC_B * 32 * 64 * 64, O_CVS = O_SHS + (size_t)DEC_B * SHIFT_W,
                 O_END = O_CVS + (size_t)DEC_B * 2 * DFF;
static_assert(O_END == 48113088, "output size");

constexpr size_t al256(size_t x) { return (x + 255) & ~(size_t)255; }
constexpr size_t WS_CTL = 0, CTL_BYTES = 1u << 20;
constexpr size_t WS_WIN = al256(WS_CTL + CTL_BYTES);
constexpr size_t WS_WADA = al256(WS_WIN + (size_t)ZLD * DM * 2);
constexpr size_t WS_WPA = al256(WS_WADA + (size_t)MODLD * DM * 2);
constexpr size_t WS_WOUT = al256(WS_WPA + (size_t)DM * 4096 * 2);
constexpr size_t WS_WUP = al256(WS_WOUT + (size_t)DM * DM * 2);
constexpr size_t WS_WDN = al256(WS_WUP + (size_t)UPN * DM * 2);
constexpr size_t WS_WDEC = al256(WS_WDN + (size_t)DM * DFF * 2);
constexpr size_t WS_WA = al256(WS_WDEC + (size_t)DM * 256 * 2);
constexpr size_t WS_WG = al256(WS_WA + (size_t)DM * 256 * 2);
constexpr size_t WS_ASILU = al256(WS_WG + (size_t)DM * 256 * 2);
constexpr size_t WS_MOD = al256(WS_ASILU + (size_t)256 * DM * 2);
constexpr size_t WS_H = al256(WS_MOD + (size_t)256 * MODLD * 4);
constexpr size_t WS_Z = al256(WS_H + (size_t)NTOK * DM * 2);
constexpr size_t WS_ADEC = al256(WS_Z + (size_t)NTOK * ZLD * 2);
constexpr size_t WS_AAIN = al256(WS_ADEC + (size_t)NTOK * 256 * 2);
constexpr size_t WS_AGIN = al256(WS_AAIN + (size_t)NTOK * 256 * 2);
constexpr size_t WS_LW = al256(WS_AGIN + (size_t)NTOK * 256 * 2);
constexpr size_t WS_AAO = al256(WS_LW + (size_t)NTOK * DM * 2);
constexpr size_t WS_GG = al256(WS_AAO + (size_t)NTOK * DM * 2);
constexpr size_t WS_RS = al256(WS_GG + (size_t)NTOK * DM * 2);
constexpr size_t WS_KS = al256(WS_RS + (size_t)NTOK * DM * 2);
constexpr size_t WS_VS = al256(WS_KS + (size_t)NTOK * DM * 2);
constexpr size_t WS_AS = al256(WS_VS + (size_t)NTOK * DM * 2);
constexpr size_t WS_BS = al256(WS_AS + (size_t)NTOK * DM * 2);
constexpr size_t WS_BON = al256(WS_BS + (size_t)NTOK * DM * 2);
constexpr size_t WS_PC = al256(WS_BON + (size_t)NTOK * 32 * 4);
constexpr size_t WS_UC = al256(WS_PC + (size_t)NCHUNK * 32 * 4096 * 4);
constexpr size_t WS_SC = al256(WS_UC + (size_t)NCHUNK * 32 * 4096 * 4);
constexpr size_t WS_OCAT = al256(WS_SC + (size_t)NCHUNK * 32 * 4096 * 4);
constexpr size_t WS_QB = al256(WS_OCAT + (size_t)NTOK * 4096 * 2);
constexpr size_t WS_KB = al256(WS_QB + (size_t)NTOK * DM * 2);
constexpr size_t WS_VB = al256(WS_KB + (size_t)NTOK * 512 * 2);
constexpr size_t WS_KIB = al256(WS_VB + (size_t)NTOK * 512 * 2);
constexpr size_t WS_WI = al256(WS_KIB + (size_t)NTOK * 64 * 2);
constexpr size_t WS_IDX = al256(WS_WI + (size_t)NTOK * 16 * 4);
constexpr size_t WS_NSEL = al256(WS_IDX + (size_t)NTOK * 256 * 4);
constexpr size_t WS_TMPA = al256(WS_NSEL + (size_t)NTOK * 4);
constexpr size_t WS_MIX = al256(WS_TMPA + (size_t)NTOK * DM * 4);
constexpr size_t WS_XM = al256(WS_MIX + (size_t)NTOK * DM * 2);
constexpr size_t WS_U = al256(WS_XM + (size_t)NTOK * DM * 4);
constexpr size_t WS_ACT = al256(WS_U + (size_t)NTOK * UPN * 2);
constexpr size_t WS_END = al256(WS_ACT + (size_t)NTOK * DFF * 2);

constexpr int LDS_BYTES = 155648;
constexpr int LDS_MISC = 147456;

typedef __bf16 bf16x2_t __attribute__((ext_vector_type(2)));
__device__ __forceinline__ unsigned cvt_pk_bf16(float lo, float hi) { f32x2 v = {lo, hi}; bf16x2_t b = __builtin_convertvector(v, bf16x2_t); return __builtin_bit_cast(unsigned, b); }
__device__ __forceinline__ float bf_lo(unsigned w) { return __uint_as_float(w << 16); }
__device__ __forceinline__ float bf_hi(unsigned w) { return __uint_as_float(w & 0xffff0000u); }
__device__ __forceinline__ float bf2f(bf16_t b) { return __uint_as_float(((unsigned)b) << 16); }
__device__ __forceinline__ bf16_t f2bf(float f) { return (bf16_t)(cvt_pk_bf16(f, 0.f) & 0xffffu); }
__device__ __forceinline__ void unpack8(const u32x4 w, float (&f)[8]) {
    f[0] = bf_lo(w.x); f[1] = bf_hi(w.x); f[2] = bf_lo(w.y); f[3] = bf_hi(w.y); f[4] = bf_lo(w.z); f[5] = bf_hi(w.z); f[6] = bf_lo(w.w); f[7] = bf_hi(w.w); }
__device__ __forceinline__ u32x4 pack8(const float (&f)[8]) { u32x4 w; w.x = cvt_pk_bf16(f[0], f[1]); w.y = cvt_pk_bf16(f[2], f[3]); w.z = cvt_pk_bf16(f[4], f[5]); w.w = cvt_pk_bf16(f[6], f[7]); return w; }
__device__ __forceinline__ float wave_sum(float x) { for (int d = 32; d >= 1; d >>= 1) x += __shfl_xor(x, d); return x; }
__device__ __forceinline__ float row16_sum(float x) { x += __shfl_xor(x, 1); x += __shfl_xor(x, 2); x += __shfl_xor(x, 4); x += __shfl_xor(x, 8); return x; }
__device__ __forceinline__ float row16_max(float x) { x = fmaxf(x, __shfl_xor(x, 1)); x = fmaxf(x, __shfl_xor(x, 2)); x = fmaxf(x, __shfl_xor(x, 4)); x = fmaxf(x, __shfl_xor(x, 8)); return x; }
__device__ __forceinline__ float sigmoidf_(float x) { return __builtin_amdgcn_rcpf(1.f + __expf(-x)); }
__device__ __forceinline__ int lane_id_fresh() { int l; asm volatile("v_mbcnt_lo_u32_b32 %0, -1, 0\n\tv_mbcnt_hi_u32_b32 %0, -1, %0" : "=v"(l)); return l; }
__device__ __forceinline__ void wave_sync() { asm volatile("s_waitcnt lgkmcnt(0)" ::: "memory"); __builtin_amdgcn_wave_barrier(); asm volatile("" ::: "memory"); }

namespace pg8 {
#define PG8_LAS __attribute__((address_space(3)))
constexpr int BM = 256, BK = 64, HALF = 128, HTB = HALF * BK * 2  , STAGE_BYTES = 8 * HTB, NXCD = 8, WGM = 8;

__host__ __device__ __forceinline__ int lds_byte(int r, int c) { const int st = (r >> 4) * 2 + (c >> 5), rr = r & 15, cc = c & 31, ob = rr * 64 + cc * 2; return st * 1024 + (ob ^ (((ob >> 9) & 1) << 5)); }
__host__ __device__ __forceinline__ void stage_rc(int b, int& R, int& C) { const int st = b / 1024, sb = b % 1024, swz = sb ^ (((sb >> 9) & 1) << 5); R = (st >> 1) * 16 + swz / 64; C = (st & 1) * 32 + (swz % 64) / 2; }
__host__ __device__ __forceinline__ int perm32(int rho) { const int n = rho >> 4, i = rho & 15; return 8 * (i >> 2) + 4 * n + (i & 3); }

struct Unit { int pm, pn; };
struct Gemm { const bf16_t* A; const bf16_t* Bt; int M, N, K, lda, ldb; };

struct StaticOrder {
    int nM, nN, nwg, G, c;
    __host__ __device__ void init(int M, int N, int G_, int c_) { nM = M / BM; nN = N / BM; nwg = nM * nN; G = G_; c = c_; }
    __host__ __device__ bool next(int i, Unit& u) const {
        const long L = (long)i * G + c; if (L >= nwg) return false;
        int wgid = (int)L; { const int q = nwg / NXCD, r = nwg % NXCD, xcd = wgid % NXCD, off = wgid / NXCD; wgid = (xcd < r ? xcd * (q + 1) : r * (q + 1) + (xcd - r) * q) + off; }
        const int nig = WGM * nN, gid = wgid / nig, fm = gid * WGM, gsz = (nM - fm) < WGM ? (nM - fm) : WGM;
        u.pm = fm + ((wgid % nig) % gsz); u.pn = (wgid % nig) / gsz; return true;
    }
    __device__ __forceinline__ void a_ready(const Unit&) const {}
    __device__ __forceinline__ void done(const Unit&) const {}
};


typedef f32x4 AccT[2][2][4][2];
__device__ __forceinline__ int mod_row(int r) { return r < SEQ ? 0 : 1 + ((r - SEQ) >> 3); }

struct EpiF32Bias {
    static constexpr bool PERM = false, AFTER_DRAIN = false;
    float* C; int ldc; const float* bias;
    __device__ __forceinline__ void operator()(const AccT& acc, const Unit& u, int wr, int wc, int fr, int fq) const {
        const int row0 = u.pm * BM + wr * 64 + fr, col0 = u.pn * BM + wc * 32 + 4 * fq;
        f32x4 bv[2][2];
#pragma unroll
        for (int bj = 0; bj < 2; ++bj)
#pragma unroll
            for (int n = 0; n < 2; ++n) bv[bj][n] = *(const f32x4*)(bias + col0 + bj * HALF + n * 16);
#pragma unroll
        for (int ai = 0; ai < 2; ++ai)
#pragma unroll
            for (int m = 0; m < 4; ++m) { float* rowp = C + (size_t)(row0 + ai * HALF + m * 16) * ldc + col0;
#pragma unroll
                for (int bj = 0; bj < 2; ++bj)
#pragma unroll
                    for (int n = 0; n < 2; ++n) *(f32x4*)(rowp + bj * HALF + n * 16) = acc[ai][bj][m][n] + bv[bj][n]; }
    }
};
template <int MODE> struct EpiBf16 {
    static constexpr bool PERM = true, AFTER_DRAIN = false;
    bf16_t* O; int ldc; const float* p;
    __device__ __forceinline__ void operator()(const AccT& acc, const Unit& u, int wr, int wc, int fr, int fq) const {
        const int row0 = u.pm * BM + wr * 64 + fr, col0 = u.pn * BM + wc * 32 + 8 * fq;
#pragma unroll
        for (int bj = 0; bj < 2; ++bj) {
            f32x4 pv0 = {0.f, 0.f, 0.f, 0.f}, pv1 = pv0;
            if (MODE) { pv0 = *(const f32x4*)(p + col0 + bj * HALF); pv1 = *(const f32x4*)(p + col0 + bj * HALF + 4); }
#pragma unroll
            for (int ai = 0; ai < 2; ++ai)
#pragma unroll
                for (int m = 0; m < 4; ++m) { bf16_t* rowp = O + (size_t)(row0 + ai * HALF + m * 16) * ldc + col0;
                    f32x4 v0 = acc[ai][bj][m][0] + pv0, v1 = acc[ai][bj][m][1] + pv1;
                    if (MODE == 1 || MODE == 2) {
                        const float sc = (MODE == 1) ? -0.60653065971f : 1.f;
#pragma unroll
                        for (int e = 0; e < 4; ++e) { v0[e] = sc * sigmoidf_(v0[e]); v1[e] = sc * sigmoidf_(v1[e]); }
                    }
                    u32x4 w; w.x = cvt_pk_bf16(v0[0], v0[1]); w.y = cvt_pk_bf16(v0[2], v0[3]); w.z = cvt_pk_bf16(v1[0], v1[1]); w.w = cvt_pk_bf16(v1[2], v1[3]);
                    *(u32x4*)(rowp + bj * HALF) = w; }
        }
    }
};
struct EpiProjA {
    static constexpr bool PERM = false, AFTER_DRAIN = false;
    float* T; const bf16_t* Z;
    __device__ __forceinline__ void operator()(const AccT& acc, const Unit& u, int wr, int wc, int fr, int fq) const {
        const int row0 = u.pm * BM + wr * 64 + fr, col0 = u.pn * BM + wc * 32 + 4 * fq;
#pragma unroll
        for (int ai = 0; ai < 2; ++ai)
#pragma unroll
            for (int m = 0; m < 4; ++m) { const int r = row0 + ai * HALF + m * 16; float* rowp = T + (size_t)r * DM + col0; const bf16_t* zp = Z + (size_t)r * ZLD + C_GA + col0;
#pragma unroll
                for (int bj = 0; bj < 2; ++bj)
#pragma unroll
                    for (int n = 0; n < 2; ++n) { const u32x2 gz = *(const u32x2*)(zp + bj * HALF + n * 16); f32x4 a = acc[ai][bj][m][n];
                        a[0] *= sigmoidf_(bf_lo(gz.x)); a[1] *= sigmoidf_(bf_hi(gz.x)); a[2] *= sigmoidf_(bf_lo(gz.y)); a[3] *= sigmoidf_(bf_hi(gz.y));
                        *(f32x4*)(rowp + bj * HALF + n * 16) = a; } }
    }
};
struct EpiProjB {
    static constexpr bool PERM = true, AFTER_DRAIN = false;
    const float* T; const bf16_t* Z; bf16_t* O;
    __device__ __forceinline__ void operator()(const AccT& acc, const Unit& u, int wr, int wc, int fr, int fq) const {
        const int row0 = u.pm * BM + wr * 64 + fr, col0 = u.pn * BM + wc * 32 + 8 * fq;
#pragma unroll
        for (int ai = 0; ai < 2; ++ai)
#pragma unroll
            for (int m = 0; m < 4; ++m) { const int r = row0 + ai * HALF + m * 16; const float* tp = T + (size_t)r * DM + col0; const bf16_t* zp = Z + (size_t)r * ZLD + C_GB + col0; bf16_t* op = O + (size_t)r * DM + col0;
#pragma unroll
                for (int bj = 0; bj < 2; ++bj) { const u32x4 gz = *(const u32x4*)(zp + bj * HALF); const f32x4 t0 = *(const f32x4*)(tp + bj * HALF), t1 = *(const f32x4*)(tp + bj * HALF + 4);
                    const f32x4 a0 = acc[ai][bj][m][0], a1 = acc[ai][bj][m][1]; float o[8];
                    o[0] = t0[0] + sigmoidf_(bf_lo(gz.x)) * a0[0]; o[1] = t0[1] + sigmoidf_(bf_hi(gz.x)) * a0[1]; o[2] = t0[2] + sigmoidf_(bf_lo(gz.y)) * a0[2]; o[3] = t0[3] + sigmoidf_(bf_hi(gz.y)) * a0[3];
                    o[4] = t1[0] + sigmoidf_(bf_lo(gz.z)) * a1[0]; o[5] = t1[1] + sigmoidf_(bf_hi(gz.z)) * a1[1]; o[6] = t1[2] + sigmoidf_(bf_lo(gz.w)) * a1[2]; o[7] = t1[3] + sigmoidf_(bf_hi(gz.w)) * a1[3];
                    *(u32x4*)(op + bj * HALF) = pack8(o); } }
    }
};
struct EpiResidual {
    static constexpr bool PERM = false, AFTER_DRAIN = false;
    const float* res_p; const float* res_s; const float* MOD; int goff; float* OUT;
    __device__ __forceinline__ void operator()(const AccT& acc, const Unit& u, int wr, int wc, int fr, int fq) const {
        const int row0 = u.pm * BM + wr * 64 + fr, col0 = u.pn * BM + wc * 32 + 4 * fq;
#pragma unroll
        for (int ai = 0; ai < 2; ++ai)
#pragma unroll
            for (int m = 0; m < 4; ++m) { const int r = row0 + ai * HALF + m * 16;
                const float* rp = (r < SEQ ? res_p + (size_t)r * DM : res_s + (size_t)(r - SEQ) * DM) + col0;
                const float* gp = MOD + (size_t)mod_row(r) * MODLD + goff + col0; float* op = OUT + (size_t)r * DM + col0;
#pragma unroll
                for (int bj = 0; bj < 2; ++bj)
#pragma unroll
                    for (int n = 0; n < 2; ++n) { const f32x4 x = *(const f32x4*)(rp + bj * HALF + n * 16), g = *(const f32x4*)(gp + bj * HALF + n * 16);
                        *(f32x4*)(op + bj * HALF + n * 16) = x + g * acc[ai][bj][m][n]; } }
    }
};
template <class Epi, class Sched, bool ALIGN_EPI = false, bool SP2 = false>
__device__ __forceinline__ void gemm_phase(PG8_LAS unsigned char* lds, const Gemm g, const Sched& S, const Epi& E, const int wid  ) {
    const int lane = lane_id_fresh(), tid = wid * 64 + lane, wr = wid >> 2, wc = wid & 3, fr = lane & 15, fq = lane >> 4;
    const int K = g.K, nt = K / BK;
    unsigned voffA[2], voffB[2];
#pragma unroll
    for (int i = 0; i < 2; ++i) { int R, C; stage_rc(tid * 16 + i * 8192, R, C); const int Rb = Epi::PERM ? ((R & ~31) + perm32(R & 31)) : R;
        voffA[i] = (unsigned)(R * g.lda + C) * 2u; voffB[i] = (unsigned)(Rb * g.ldb + C) * 2u; }
    const size_t kstep = (size_t)(BK * 2);
    const size_t hstepA = (size_t)HALF * g.lda * 2, hstepB = (size_t)HALF * g.ldb * 2;
    const size_t tstepA = 2 * hstepA, tstepB = 2 * hstepB;
    const unsigned ldsw = (unsigned)wid * 1024u;
    const int aoff = lds_byte(wr * 64 + fr, fq * 8), boff = lds_byte(wc * 32 + fr, fq * 8);
#define PG8_SA(b, h) (((b) * 2 + (h)) * HTB)
#define PG8_SB(b, h) ((4 + (b) * 2 + (h)) * HTB)
#define PG8_STAGE(bufoff, gbase, voff) do { _Pragma("unroll") for (int _i = 0; _i < 2; ++_i) \
        __builtin_amdgcn_global_load_lds((const unsigned*)((const char*)(gbase) + (voff)[_i]), (PG8_LAS unsigned*)(lds + (bufoff) + ldsw + _i * 8192), 16, 0, 0); } while (0)
#define PG8_LDA(dst, b, h) do { _Pragma("unroll") for (int m = 0; m < 4; ++m) _Pragma("unroll") for (int k = 0; k < 2; ++k) dst[m][k] = *(const PG8_LAS bf16x8*)(lds + PG8_SA(b, h) + aoff + m * 2048 + k * 1024); } while (0)
#define PG8_LDB(dst, b, h) do { _Pragma("unroll") for (int n = 0; n < 2; ++n) _Pragma("unroll") for (int k = 0; k < 2; ++k) dst[n][k] = *(const PG8_LAS bf16x8*)(lds + PG8_SB(b, h) + boff + n * 2048 + k * 1024); } while (0)
#define PG8_MMA(ai, bj, At, Bt) do { __builtin_amdgcn_s_setprio(1); _Pragma("unroll") for (int m = 0; m < 4; ++m) _Pragma("unroll") for (int n = 0; n < 2; ++n) _Pragma("unroll") for (int k = 0; k < 2; ++k) \
        acc[ai][bj][m][n] = __builtin_amdgcn_mfma_f32_16x16x32_bf16(Bt[n][k], At[m][k], acc[ai][bj][m][n], 0, 0, 0); __builtin_amdgcn_s_setprio(0); } while (0)
#define PG8_WAIT_V(n) asm volatile("s_waitcnt vmcnt(" #n ")" ::: "memory")
#define PG8_WAIT_L(n) asm volatile("s_waitcnt lgkmcnt(" #n ")" ::: "memory")
#define PG8_BAR __builtin_amdgcn_s_barrier()
#define PG8_SCHED __builtin_amdgcn_sched_barrier(0)
    Unit cur, nxt; int ui = 0;
    if (!S.next(0, cur)) return;
    f32x4 acc[2][2][4][2];
#pragma unroll
    for (int a = 0; a < 2; ++a)
#pragma unroll
        for (int b = 0; b < 2; ++b)
#pragma unroll
            for (int m = 0; m < 4; ++m)
#pragma unroll
                for (int n = 0; n < 2; ++n) acc[a][b][m][n] = (f32x4){0.f, 0.f, 0.f, 0.f};
    bf16x8 At[4][2], B0[2][2], B1[2][2];
    const char* cA = (const char*)g.A + (size_t)cur.pm * tstepA; const char* cB = (const char*)g.Bt + (size_t)cur.pn * tstepB;
    S.a_ready(cur);
    if constexpr (SP2) {
        PG8_STAGE(PG8_SB(0, 0), cB, voffB); PG8_STAGE(PG8_SB(0, 1), cB + hstepB, voffB); PG8_STAGE(PG8_SA(0, 0), cA, voffA); PG8_STAGE(PG8_SA(0, 1), cA + hstepA, voffA);
        if (wr == 1) PG8_BAR;
        PG8_WAIT_V(2); PG8_BAR;
        PG8_STAGE(PG8_SB(1, 0), cB + kstep, voffB); PG8_STAGE(PG8_SA(1, 0), cA + kstep, voffA); PG8_STAGE(PG8_SB(1, 1), cB + hstepB + kstep, voffB);
        PG8_WAIT_V(6); PG8_BAR;
    } else {
        PG8_STAGE(PG8_SB(0, 0), cB, voffB); PG8_STAGE(PG8_SA(0, 0), cA, voffA); PG8_STAGE(PG8_SB(0, 1), cB + hstepB, voffB); PG8_STAGE(PG8_SA(0, 1), cA + hstepA, voffA);
        if (wr == 1) PG8_BAR;
        PG8_WAIT_V(4); PG8_BAR;
        PG8_STAGE(PG8_SB(1, 0), cB + kstep, voffB); PG8_STAGE(PG8_SA(1, 0), cA + kstep, voffA); PG8_STAGE(PG8_SB(1, 1), cB + hstepB + kstep, voffB);
        PG8_WAIT_V(6); PG8_BAR;
    }
    for (;;) {
        const bool has_next = S.next(ui + 1, nxt);
        const char* nA = has_next ? (const char*)g.A + (size_t)nxt.pm * tstepA : cA; const char* nB = has_next ? (const char*)g.Bt + (size_t)nxt.pn * tstepB : cB;
#pragma unroll 1
        for (int t = 0; t < nt; t += 2) {
            const bool last = (t == nt - 2);
            const char* a1 = cA + (size_t)(t + 1) * kstep;
            const char* a2 = last ? nA : cA + (size_t)(t + 2) * kstep; const char* b2 = last ? nB : cB + (size_t)(t + 2) * kstep;
            const char* a3 = a2 + kstep; const char* b3 = b2 + kstep;
            if (last && has_next) S.a_ready(nxt);
            if constexpr (SP2) {
            PG8_LDB(B0, 0, 0); PG8_LDB(B1, 0, 1); PG8_SCHED; PG8_LDA(At, 0, 0); PG8_STAGE(PG8_SA(1, 1), a1 + hstepA, voffA);
            PG8_WAIT_V(8); PG8_WAIT_L(0); PG8_BAR; PG8_MMA(0, 0, At, B0); PG8_MMA(0, 1, At, B1); PG8_BAR; PG8_SCHED;
            PG8_LDA(At, 0, 1); PG8_STAGE(PG8_SB(0, 0), b2, voffB); PG8_STAGE(PG8_SB(0, 1), b2 + hstepB, voffB); PG8_STAGE(PG8_SA(0, 0), a2, voffA);
            PG8_WAIT_V(8); PG8_WAIT_L(0); PG8_BAR; PG8_MMA(1, 0, At, B0); PG8_MMA(1, 1, At, B1); PG8_BAR; PG8_SCHED;
            PG8_LDB(B0, 1, 0); PG8_LDB(B1, 1, 1); PG8_SCHED; PG8_LDA(At, 1, 0); PG8_STAGE(PG8_SA(0, 1), a2 + hstepA, voffA);
            PG8_WAIT_V(8); PG8_WAIT_L(0); PG8_BAR; PG8_MMA(0, 0, At, B0); PG8_MMA(0, 1, At, B1); PG8_BAR; PG8_SCHED;
            PG8_LDA(At, 1, 1); PG8_STAGE(PG8_SB(1, 0), b3, voffB); PG8_STAGE(PG8_SB(1, 1), b3 + hstepB, voffB); PG8_STAGE(PG8_SA(1, 0), a3, voffA);
            PG8_WAIT_V(8); PG8_WAIT_L(0); PG8_BAR; PG8_MMA(1, 0, At, B0); PG8_MMA(1, 1, At, B1); PG8_BAR; PG8_SCHED;
            } else {
            PG8_LDB(B0, 0, 0); PG8_SCHED; PG8_LDA(At, 0, 0); PG8_STAGE(PG8_SA(1, 1), a1 + hstepA, voffA);
            PG8_WAIT_L(8); PG8_BAR; PG8_WAIT_L(0); PG8_MMA(0, 0, At, B0); PG8_BAR; PG8_SCHED;
            PG8_LDB(B1, 0, 1); PG8_STAGE(PG8_SB(0, 0), b2, voffB);
            PG8_BAR; PG8_WAIT_L(0); PG8_MMA(0, 1, At, B1); PG8_BAR;
            PG8_LDA(At, 0, 1); PG8_STAGE(PG8_SA(0, 0), a2, voffA);
            PG8_BAR; PG8_WAIT_L(0); PG8_MMA(1, 0, At, B0); PG8_BAR; PG8_SCHED;
            PG8_STAGE(PG8_SB(0, 1), b2 + hstepB, voffB);
            PG8_WAIT_V(6); PG8_BAR; PG8_MMA(1, 1, At, B1); PG8_BAR;
            PG8_LDB(B0, 1, 0); PG8_SCHED; PG8_LDA(At, 1, 0); PG8_STAGE(PG8_SA(0, 1), a2 + hstepA, voffA);
            PG8_WAIT_L(8); PG8_BAR; PG8_WAIT_L(0); PG8_MMA(0, 0, At, B0); PG8_BAR; PG8_SCHED;
            PG8_LDB(B1, 1, 1); PG8_STAGE(PG8_SB(1, 0), b3, voffB);
            PG8_BAR; PG8_WAIT_L(0); PG8_MMA(0, 1, At, B1); PG8_BAR;
            PG8_LDA(At, 1, 1); PG8_STAGE(PG8_SA(1, 0), a3, voffA);
            PG8_BAR; PG8_WAIT_L(0); PG8_MMA(1, 0, At, B0); PG8_BAR; PG8_SCHED;
            PG8_STAGE(PG8_SB(1, 1), b3 + hstepB, voffB);
            PG8_WAIT_V(6); PG8_BAR; PG8_MMA(1, 1, At, B1); PG8_BAR;
            }
        }
        if constexpr (ALIGN_EPI) { if (wr == 0) PG8_BAR; }
        if constexpr (!Epi::AFTER_DRAIN) { E(acc, cur, wr, wc, fr, fq); S.done(cur); }
        if (!has_next) break;
#pragma unroll
        for (int a = 0; a < 2; ++a)
#pragma unroll
            for (int b = 0; b < 2; ++b)
#pragma unroll
                for (int m = 0; m < 4; ++m)
#pragma unroll
                    for (int n = 0; n < 2; ++n) acc[a][b][m][n] = (f32x4){0.f, 0.f, 0.f, 0.f};
        cur = nxt; cA = nA; cB = nB; ++ui;
        if constexpr (ALIGN_EPI) { if (wr == 1) PG8_BAR; }
    }
    PG8_WAIT_V(0);
    if constexpr (!ALIGN_EPI) { if (wr == 0) PG8_BAR; }
    PG8_BAR;
    if constexpr (Epi::AFTER_DRAIN) { E.fused(acc, cur, wr, wc, fr, fq, lds, wid, lane); S.done(cur); }
#undef PG8_SA
#undef PG8_SB
#undef PG8_STAGE
#undef PG8_LDA
#undef PG8_LDB
#undef PG8_MMA
#undef PG8_WAIT_V
#undef PG8_WAIT_L
#undef PG8_BAR
#undef PG8_SCHED
}
}
#define XB_TMO      128
#define XB_XCNT(j)  (256  + 64 * (j))
#define XB_XSUB(j)  (1280 + 64 * (j))
#define XB_XGEN(j)  (2304 + 64 * (j))
#define XB_TOP      3328
#define XB_TOPGEN   3392
#define XCD_BAR_WORDS 3456
#define XB_SPIN_CAP (1u << 18)

__device__ __forceinline__ unsigned xb_ld(unsigned* p)              { return __hip_atomic_load(p, __ATOMIC_RELAXED, __HIP_MEMORY_SCOPE_AGENT); }
__device__ __forceinline__ unsigned xb_add(unsigned* p, unsigned v) { return __hip_atomic_fetch_add(p, v, __ATOMIC_RELAXED, __HIP_MEMORY_SCOPE_AGENT); }
__device__ __forceinline__ unsigned xb_xcc_id() { return (unsigned)__builtin_amdgcn_s_getreg((3 << 11) | 20) & 0xFu; }
#define XB_SPIN(cond, bar) do { unsigned _sp = 0; while (cond) { __builtin_amdgcn_s_sleep(1); \
    if ((++_sp & 255u) == 0u) { if (xb_ld(&(bar)[XB_TMO])) break; if (_sp > XB_SPIN_CAP) { atomicAdd(&(bar)[XB_TMO], 1u); break; } } } } while (0)

struct XcdBarrier {
    unsigned* bar; unsigned x;
    volatile LAS unsigned* st;
};

__device__ __forceinline__ XcdBarrier xcd_barrier_post(unsigned* bar, volatile LAS unsigned* st) {
    XcdBarrier b; b.bar = bar; b.x = xb_xcc_id(); b.st = st;
    if (threadIdx.x == 0) (void)xb_add(&bar[XB_XCNT(b.x)], 1u);
    return b;
}
__device__ __forceinline__ void xcd_barrier_complete(unsigned* bar, unsigned x, unsigned& nloc, unsigned& nx) {
    const unsigned G = gridDim.x * gridDim.y * gridDim.z;
    unsigned sum, cnt, mine, sp = 0u;
    for (;;) {
        sum = 0u; cnt = 0u; mine = 0u;
#pragma unroll
        for (unsigned j = 0; j < 16; ++j) { const unsigned c = xb_ld(&bar[XB_XCNT(j)]); sum += c; cnt += (c > 0u) ? 1u : 0u; mine = (j == x) ? c : mine; }
        if (sum == G) break;
        __builtin_amdgcn_s_sleep(1);
        if ((++sp & 255u) == 0u) { if (xb_ld(&bar[XB_TMO])) break; if (sp > XB_SPIN_CAP) { atomicAdd(&bar[XB_TMO], 1u); break; } }
    }
    nloc = mine > 0u ? mine : 1u; nx = cnt > 0u ? cnt : 1u;
}

__device__ __forceinline__ void xcd_barrier(const XcdBarrier& b) {
    asm volatile("s_waitcnt vmcnt(0)" ::: "memory");
    __syncthreads();
    if (threadIdx.x == 0) {
        unsigned* bar = b.bar;
        __builtin_amdgcn_s_waitcnt(0);
        unsigned nloc = b.st[0], nx = b.st[1];
        if (nloc == 0u) { xcd_barrier_complete(bar, b.x, nloc, nx); b.st[0] = nloc; b.st[1] = nx; }
        const unsigned old = xb_add(&bar[XB_XSUB(b.x)], 1u);
        const unsigned gen = old / nloc;
        if (old + 1u == (gen + 1u) * nloc) {
            __builtin_amdgcn_fence(__ATOMIC_RELEASE, "agent");
            asm volatile("s_waitcnt vmcnt(0)" ::: "memory");
            const unsigned og = xb_add(&bar[XB_TOP], 1u);
            const unsigned tg = og / nx;
            if (og + 1u == (tg + 1u) * nx) xb_add(&bar[XB_TOPGEN], 1u);
            else XB_SPIN(xb_ld(&bar[XB_TOPGEN]) == tg, bar);
            __builtin_amdgcn_fence(__ATOMIC_ACQUIRE, "agent");
            xb_add(&bar[XB_XGEN(b.x)], 1u);
            asm volatile("s_waitcnt vmcnt(0)" ::: "memory");
        } else {
            XB_SPIN(xb_ld(&bar[XB_XGEN(b.x)]) == gen, bar);
            __builtin_amdgcn_fence(__ATOMIC_ACQUIRE, "agent");
            asm volatile("s_waitcnt vmcnt(0)" ::: "memory");
        }
    }
    __syncthreads();
}

typedef const float* InPtr;
typedef const __attribute__((address_space(4))) InPtr* KTab;
struct Ctx {
    KTab in; float* out; unsigned char* ws;
    LAS unsigned char* lds; int tid, lane, wave, G, bid;
    template <class T> __device__ __forceinline__ T* W(size_t off) const { return (T*)(ws + off); }
};
enum { I_XP = 0, I_XS, I_CP, I_CS, I_CK, I_CV, I_CKI, I_PT, I_SRW, I_SSH, I_SCV, I_WADA, I_BADA, I_N1G, I_N2G, I_WIN, I_MU, I_W0, I_WDEC, I_A0, I_WAUP, I_WGUP,
       I_KK, I_KA, I_RK, I_LNW, I_LNB, I_QNG, I_KNG, I_WPA, I_WPB, I_WOUT, I_WUP, I_CW, I_CB, I_WDN };

__device__ __forceinline__ void tconv(const Ctx& X, const float* __restrict__ src, int K, int N, bf16_t* __restrict__ dst, int ldd, int Kpad, int Npad) {
    const int nkt = Kpad / 64, nnt = Npad / 64, ntile = nkt * nnt;
    LAS unsigned short* tile = (LAS unsigned short*)X.lds;
    const int tid = X.tid;
    for (int ti = X.bid; ti < ntile; ti += X.G) {
        const int kt = ti % nkt, nt = ti / nkt;
        const int kr = tid >> 4, nq = tid & 15;
#pragma unroll
        for (int p = 0; p < 2; ++p) {
            const int k = kt * 64 + kr + 32 * p, n = nt * 64 + 4 * nq;
            f32x4 v = {0.f, 0.f, 0.f, 0.f};
            if (k < K && n < N) v = *(const f32x4*)(src + (size_t)k * N + n);
            u32x2 w; w.x = cvt_pk_bf16(v[0], v[1]); w.y = cvt_pk_bf16(v[2], v[3]);
            *(LAS u32x2*)(tile + (kr + 32 * p) * 68 + 4 * nq) = w;
        }
        __syncthreads();
        {
            const int n = tid & 63, kg = tid >> 6;
            unsigned short e[8];
#pragma unroll
            for (int j = 0; j < 8; ++j) e[j] = tile[(8 * kg + j) * 68 + n];
            u32x4 w; w.x = e[0] | ((unsigned)e[1] << 16); w.y = e[2] | ((unsigned)e[3] << 16); w.z = e[4] | ((unsigned)e[5] << 16); w.w = e[6] | ((unsigned)e[7] << 16);
            *(u32x4*)(dst + (size_t)(nt * 64 + n) * ldd + kt * 64 + 8 * kg) = w;
        }
        __syncthreads();
    }
}

__device__ __forceinline__ void phase_convert(const Ctx& X) {
    tconv(X, X.in[I_WIN], DM, IN_COLS, X.W<bf16_t>(WS_WIN), DM, DM, ZLD);
    tconv(X, X.in[I_WADA], DM, MODLD, X.W<bf16_t>(WS_WADA), DM, DM, MODLD);
    tconv(X, X.in[I_WPA], DM, DM, X.W<bf16_t>(WS_WPA), 4096, DM, DM);
    tconv(X, X.in[I_WPB], DM, DM, X.W<bf16_t>(WS_WPA) + 2048, 4096, DM, DM);
    tconv(X, X.in[I_WOUT], DM, DM, X.W<bf16_t>(WS_WOUT), DM, DM, DM);
    tconv(X, X.in[I_WUP], DM, UPN, X.W<bf16_t>(WS_WUP), DM, DM, UPN);
    tconv(X, X.in[I_WDN], DFF, DM, X.W<bf16_t>(WS_WDN), DFF, DFF, DM);
    tconv(X, X.in[I_WDEC], 96, DM, X.W<bf16_t>(WS_WDEC), 256, 256, DM);
    tconv(X, X.in[I_WAUP], 96, DM, X.W<bf16_t>(WS_WA), 256, 256, DM);
    tconv(X, X.in[I_WGUP], 256, DM, X.W<bf16_t>(WS_WG), 256, 256, DM);
    bf16_t* as = X.W<bf16_t>(WS_ASILU);
    for (int i = X.bid * 512 + X.tid; i < 256 * DM; i += X.G * 512) {
        const int r = i >> 11, c = i & 2047; float v = 0.f;
        if (r == 0) v = X.in[I_CP][c]; else if (r <= DEC_B) v = X.in[I_CS][(size_t)(r - 1) * DM + c];
        as[i] = (r <= DEC_B) ? f2bf(v * sigmoidf_(v)) : (bf16_t)0;
    }
}

__device__ __forceinline__ void phase_norm_mod(const Ctx& X, const float* xp, const float* xs, const float* gn, int sh_off, int sc_off, bf16_t* dst) {
    const float* MOD = X.W<float>(WS_MOD);
    const int lane = X.lane;
    for (int t = X.bid * 8 + X.wave; t < NTOK; t += X.G * 8) {
        const float* x = t < SEQ ? xp + (size_t)t * DM : xs + (size_t)(t - SEQ) * DM;
        const float* mr = MOD + (size_t)(t < SEQ ? 0 : 1 + ((t - SEQ) >> 3)) * MODLD;
        f32x4 v[8]; float ss = 0.f;
#pragma unroll
        for (int i = 0; i < 8; ++i) { v[i] = ((const f32x4*)x)[lane + 64 * i]; ss += v[i][0] * v[i][0] + v[i][1] * v[i][1] + v[i][2] * v[i][2] + v[i][3] * v[i][3]; }
        ss = wave_sum(ss);
        const float rs = rsqrtf(ss * (1.f / DM) + 1e-6f);
#pragma unroll
        for (int i = 0; i < 8; ++i) { const int c = 4 * (lane + 64 * i);
            const f32x4 g = *(const f32x4*)(gn + c), sc = *(const f32x4*)(mr + sc_off + c), sh = *(const f32x4*)(mr + sh_off + c);
            f32x4 y;
#pragma unroll
            for (int e = 0; e < 4; ++e) y[e] = v[i][e] * rs * g[e] * (1.f + sc[e]) + sh[e];
            u32x2 w; w.x = cvt_pk_bf16(y[0], y[1]); w.y = cvt_pk_bf16(y[2], y[3]);
            *(u32x2*)(dst + (size_t)t * DM + c) = w; }
    }
}

__device__ __forceinline__ void phase_prep1(const Ctx& X) {
    const bf16_t* Z = X.W<bf16_t>(WS_Z);
    const float* mu = X.in[I_MU];
    bf16_t* ADEC = X.W<bf16_t>(WS_ADEC); bf16_t* AAIN = X.W<bf16_t>(WS_AAIN); bf16_t* AGIN = X.W<bf16_t>(WS_AGIN);
    bf16_t* QB = X.W<bf16_t>(WS_QB); bf16_t* KB = X.W<bf16_t>(WS_KB); bf16_t* VB = X.W<bf16_t>(WS_VB); bf16_t* KIB = X.W<bf16_t>(WS_KIB); float* WI = X.W<float>(WS_WI);
    const int lane = X.lane;
    for (int t = X.bid * 8 + X.wave; t < NTOK; t += X.G * 8) {
        const bf16_t* zr = Z + (size_t)t * ZLD;
        const bool smp = t >= SEQ; const int tt = smp ? t - SEQ : t; const int p = smp ? (tt & 7) : t; const int b = tt >> 3;
#pragma unroll
        for (int i = 0; i < 7; ++i) { const int c = C_WD + lane + 64 * i;
            const float zc = bf2f(zr[c]);
            float zp = 0.f; if (p > 0) zp = bf2f(zr[c - ZLD]); else if (smp) zp = X.in[I_SSH][(size_t)b * SHIFT_W + c];
            const float zs = zc + (zp - zc) * mu[c];
            if (c < C_AD) ADEC[(size_t)t * 256 + (c - C_WD)] = f2bf(tanhf(zs));
            else if (c < C_GD) AAIN[(size_t)t * 256 + (c - C_AD)] = f2bf(zs);
            else AGIN[(size_t)t * 256 + (c - C_GD)] = f2bf(sigmoidf_(zs)); }
        for (int c = 96 + lane; c < 256; c += 64) { ADEC[(size_t)t * 256 + c] = 0; AAIN[(size_t)t * 256 + c] = 0; }
#pragma unroll
        for (int i = 0; i < 4; ++i) { const int e = 8 * (lane + 64 * i); float f[8]; unpack8(*(const u32x4*)(zr + C_Q + e), f);
            float ss = 0.f;
#pragma unroll
            for (int j = 0; j < 8; ++j) ss += f[j] * f[j];
            ss = row16_sum(ss); const float rs = rsqrtf(ss * (1.f / 128.f) + 1e-6f) * 0.08838834764831845f;
            const float* g = X.in[I_QNG] + (e & 127);
#pragma unroll
            for (int j = 0; j < 8; ++j) f[j] = f[j] * rs * g[j];
            *(u32x4*)(QB + (size_t)t * DM + e) = pack8(f); }
        { const int e = 8 * lane; float f[8]; unpack8(*(const u32x4*)(zr + C_KK + e), f);
            float ss = 0.f;
#pragma unroll
            for (int j = 0; j < 8; ++j) ss += f[j] * f[j];
            ss = row16_sum(ss); const float rs = rsqrtf(ss * (1.f / 128.f) + 1e-6f);
            const float* g = X.in[I_KNG] + (e & 127);
#pragma unroll
            for (int j = 0; j < 8; ++j) f[j] = f[j] * rs * g[j];
            *(u32x4*)(KB + (size_t)t * 512 + e) = pack8(f);
            float* ko = X.out + (smp ? O_KS : O_KP) + (size_t)tt * 512 + e;
            *(f32x4*)ko = (f32x4){f[0], f[1], f[2], f[3]}; *(f32x4*)(ko + 4) = (f32x4){f[4], f[5], f[6], f[7]};
            const u32x4 vw = *(const u32x4*)(zr + C_VV + e); unpack8(vw, f);
            *(u32x4*)(VB + (size_t)t * 512 + e) = vw;
            float* vo = X.out + (smp ? O_VS : O_VP) + (size_t)tt * 512 + e;
            *(f32x4*)vo = (f32x4){f[0], f[1], f[2], f[3]}; *(f32x4*)(vo + 4) = (f32x4){f[4], f[5], f[6], f[7]}; }
        if (lane < 8) { const int e = 8 * lane; float f[8]; const u32x4 kw = *(const u32x4*)(zr + C_KI + e); unpack8(kw, f);
            *(u32x4*)(KIB + (size_t)t * 64 + e) = kw;
            float* ko = X.out + (smp ? O_KIS : O_KIP) + (size_t)tt * 64 + e;
            *(f32x4*)ko = (f32x4){f[0], f[1], f[2], f[3]}; *(f32x4*)(ko + 4) = (f32x4){f[4], f[5], f[6], f[7]}; }
        if (lane < 16) WI[(size_t)t * 16 + lane] = bf2f(zr[C_WI + lane]) * 0.03125f;
        if (t == SEQ - 1 || (smp && p == 7)) { float* so = X.out + (smp ? O_SHS + (size_t)b * SHIFT_W : O_SHP);
            for (int c = lane; c < SHIFT_W; c += 64) so[c] = bf2f(zr[c]); }
    }
}

__device__ __forceinline__ void phase_prep2(const Ctx& X) {
    const bf16_t* Z = X.W<bf16_t>(WS_Z); const bf16_t* AAO = X.W<bf16_t>(WS_AAO);
    const float* mu = X.in[I_MU];
    bf16_t* RS = X.W<bf16_t>(WS_RS); bf16_t* KS = X.W<bf16_t>(WS_KS); bf16_t* VS = X.W<bf16_t>(WS_VS); bf16_t* AS = X.W<bf16_t>(WS_AS); bf16_t* BS = X.W<bf16_t>(WS_BS);
    float* BON = X.W<float>(WS_BON);
    const int lane = X.lane;
    for (int t = X.bid * 8 + X.wave; t < NTOK; t += X.G * 8) {
        const bf16_t* zr = Z + (size_t)t * ZLD;
        const bool smp = t >= SEQ; const int tt = smp ? t - SEQ : t; const int p = smp ? (tt & 7) : t; const int b = tt >> 3;
        const float* sprev = X.in[I_SSH] + (size_t)b * SHIFT_W;
#pragma unroll
        for (int i = 0; i < 4; ++i) { const int e = 8 * (lane + 64 * i);
            float r[8], k[8], v[8], a[8], pr[8], pk[8], pv[8];
            unpack8(*(const u32x4*)(zr + C_R + e), r); unpack8(*(const u32x4*)(zr + C_K + e), k); unpack8(*(const u32x4*)(zr + C_V + e), v);
            unpack8(*(const u32x4*)(AAO + (size_t)t * DM + e), a);
            if (p > 0) { unpack8(*(const u32x4*)(zr - ZLD + C_R + e), pr); unpack8(*(const u32x4*)(zr - ZLD + C_K + e), pk); unpack8(*(const u32x4*)(zr - ZLD + C_V + e), pv); }
            else if (smp) {
#pragma unroll
                for (int j = 0; j < 8; ++j) { pr[j] = sprev[C_R + e + j]; pk[j] = sprev[C_K + e + j]; pv[j] = sprev[C_V + e + j]; } }
            else {
#pragma unroll
                for (int j = 0; j < 8; ++j) { pr[j] = 0.f; pk[j] = 0.f; pv[j] = 0.f; } }
            float kk[8], kp[8], bs[8], ss = 0.f, bo = 0.f;
#pragma unroll
            for (int j = 0; j < 8; ++j) {
                r[j] = r[j] + (pr[j] - r[j]) * mu[C_R + e + j]; k[j] = k[j] + (pk[j] - k[j]) * mu[C_K + e + j]; v[j] = v[j] + (pv[j] - v[j]) * mu[C_V + e + j];
                kk[j] = k[j] * X.in[I_KK][e + j]; ss += kk[j] * kk[j];
                kp[j] = k[j] * (1.f + (a[j] - 1.f) * X.in[I_KA][e + j]);
                bo += r[j] * kp[j] * X.in[I_RK][e + j]; }
            ss += __shfl_xor(ss, 1); ss += __shfl_xor(ss, 2); ss += __shfl_xor(ss, 4);
            bo += __shfl_xor(bo, 1); bo += __shfl_xor(bo, 2); bo += __shfl_xor(bo, 4);
            const float inv = 1.f / fmaxf(sqrtf(ss), 1e-12f);
#pragma unroll
            for (int j = 0; j < 8; ++j) { kk[j] *= inv; bs[j] = kk[j] * a[j]; kk[j] = -kk[j]; }
            *(u32x4*)(RS + (size_t)t * DM + e) = pack8(r); *(u32x4*)(KS + (size_t)t * DM + e) = pack8(kp); *(u32x4*)(VS + (size_t)t * DM + e) = pack8(v);
            *(u32x4*)(AS + (size_t)t * DM + e) = pack8(kk); *(u32x4*)(BS + (size_t)t * DM + e) = pack8(bs);
            if ((lane & 7) == 0) BON[(size_t)t * 32 + (e >> 6)] = bo; }
    }
}

constexpr int SCAN_WLDS = 8 * 1536;
struct ScanRegs { u32x4 v[6]; };
__device__ __forceinline__ void scan_load(const Ctx& X, ScanRegs& R, int tok0, int h, int lane, bool need_r, bool need_v) {
    const size_t off = (size_t)(tok0 + (lane >> 3)) * DM + h * 64 + (lane & 7) * 8;
    R.v[0] = *(const u32x4*)(X.W<bf16_t>(WS_AS) + off); R.v[1] = *(const u32x4*)(X.W<bf16_t>(WS_LW) + off); R.v[2] = *(const u32x4*)(X.W<bf16_t>(WS_BS) + off);
    R.v[3] = *(const u32x4*)(X.W<bf16_t>(WS_KS) + off);
    if (need_r) R.v[4] = *(const u32x4*)(X.W<bf16_t>(WS_RS) + off);
    if (need_v) R.v[5] = *(const u32x4*)(X.W<bf16_t>(WS_VS) + off);
}
__device__ __forceinline__ void scan_store(LAS float* wl, const ScanRegs& R, int lane, bool need_r, bool need_v) {
    LAS float* base = wl + (lane >> 3) * 384 + (lane & 7) * 8;
#pragma unroll
    for (int vi = 0; vi < 6; ++vi) {
        if ((vi == 4 && !need_r) || (vi == 5 && !need_v)) continue;
        float f[8]; unpack8(R.v[vi], f);
        if (vi == 1) {
#pragma unroll
            for (int j = 0; j < 8; ++j) f[j] = __expf(f[j]); }
        *(LAS f32x4*)(base + vi * 64) = (f32x4){f[0], f[1], f[2], f[3]}; *(LAS f32x4*)(base + vi * 64 + 4) = (f32x4){f[4], f[5], f[6], f[7]};
    }
}
#define CBAR() asm volatile("" ::: "memory")
template <bool HAS_V, bool HAS_OUT>
__device__ __forceinline__ float scan_step(float (&S)[64], const LAS float* sv, int lane) {
    const LAS f32x4* A4 = (const LAS f32x4*)sv;
    float s0 = 0.f, s1 = 0.f, s2 = 0.f, s3 = 0.f;
#pragma unroll
    for (int q = 0; q < 16; ++q) { const f32x4 a = A4[q]; s0 = fmaf(S[4 * q], a[0], s0); s1 = fmaf(S[4 * q + 1], a[1], s1); s2 = fmaf(S[4 * q + 2], a[2], s2); s3 = fmaf(S[4 * q + 3], a[3], s3);
        if ((q & 7) == 7) CBAR(); }
    const float sa = (s0 + s1) + (s2 + s3);
    const float vi = HAS_V ? sv[320 + lane] : 0.f;
    float o0 = 0.f, o1 = 0.f, o2 = 0.f, o3 = 0.f;
#pragma unroll
    for (int q = 0; q < 16; ++q) { const f32x4 w = A4[16 + q], b = A4[32 + q];
        if (HAS_V) { const f32x4 k = A4[48 + q];
            S[4 * q] = fmaf(S[4 * q], w[0], fmaf(sa, b[0], vi * k[0])); S[4 * q + 1] = fmaf(S[4 * q + 1], w[1], fmaf(sa, b[1], vi * k[1]));
            S[4 * q + 2] = fmaf(S[4 * q + 2], w[2], fmaf(sa, b[2], vi * k[2])); S[4 * q + 3] = fmaf(S[4 * q + 3], w[3], fmaf(sa, b[3], vi * k[3]));
        } else {
            S[4 * q] = fmaf(S[4 * q], w[0], sa * b[0]); S[4 * q + 1] = fmaf(S[4 * q + 1], w[1], sa * b[1]);
            S[4 * q + 2] = fmaf(S[4 * q + 2], w[2], sa * b[2]); S[4 * q + 3] = fmaf(S[4 * q + 3], w[3], sa * b[3]); }
        if (HAS_OUT) { const f32x4 r = A4[64 + q]; o0 = fmaf(S[4 * q], r[0], o0); o1 = fmaf(S[4 * q + 1], r[1], o1); o2 = fmaf(S[4 * q + 2], r[2], o2); o3 = fmaf(S[4 * q + 3], r[3], o3); }
        if ((q & 3) == 3) CBAR();
    }
    return (o0 + o1) + (o2 + o3);
}

__device__ __forceinline__ void phase_scan_a(const Ctx& X) {
    LAS float* wl = (LAS float*)(X.lds + X.wave * SCAN_WLDS);
    float* PC = X.W<float>(WS_PC); float* UC = X.W<float>(WS_UC);
    const int lane = X.lane;
    for (int id = X.bid * 8 + X.wave; id < NCHUNK * 32 * 2; id += X.G * 8) {
        const int role = id & 1, task = id >> 1, c = task >> 5, h = task & 31, tok0 = c * CHUNK;
        float S[64];
        int ln = (role == 1) ? lane : -1; asm volatile("" : "+v"(ln));
#pragma unroll
        for (int j = 0; j < 64; ++j) S[j] = (j == ln) ? 1.f : 0.f;
        ScanRegs R; scan_load(X, R, tok0, h, lane, false, role == 0);
        for (int sb = 0; sb < CHUNK / 8; ++sb) {
            scan_store(wl, R, lane, false, role == 0);
            wave_sync();
            if (sb + 1 < CHUNK / 8) scan_load(X, R, tok0 + 8 * (sb + 1), h, lane, false, role == 0);
            if (role == 0) {
#pragma unroll 1
                for (int s = 0; s < 8; ++s) scan_step<true, false>(S, wl + s * 384, lane);
            } else {
#pragma unroll 1
                for (int s = 0; s < 8; ++s) scan_step<false, false>(S, wl + s * 384, lane);
            }
            wave_sync();
        }
        float* dst = (role == 0 ? UC : PC) + ((size_t)(c * 32 + h) * 64 + lane) * 64;
#pragma unroll
        for (int q = 0; q < 16; ++q) *(f32x4*)(dst + 4 * q) = (f32x4){S[4 * q], S[4 * q + 1], S[4 * q + 2], S[4 * q + 3]};
    }
}

__device__ __forceinline__ void phase_scan_b(const Ctx& X) {
    if (X.bid >= 128) return;
    const int h = X.bid >> 2, rg = X.bid & 3, tid = X.tid, r = tid >> 5, jq = tid & 31;
    LAS float* sS = (LAS float*)X.lds;
    LAS f32x4* sP = (LAS f32x4*)(X.lds + 4096);
    const float* PC = X.W<float>(WS_PC); const float* UC = X.W<float>(WS_UC); float* SC = X.W<float>(WS_SC);
    sS[2 * tid] = 0.f; sS[2 * tid + 1] = 0.f;
    f32x4 p0 = ((const f32x4*)(PC + (size_t)h * 4096))[2 * tid], p1 = ((const f32x4*)(PC + (size_t)h * 4096))[2 * tid + 1];
    f32x2 uu = *(const f32x2*)(UC + (size_t)h * 4096 + (16 * rg + r) * 64 + 2 * jq);
    for (int c = 0; c < NCHUNK; ++c) {
        LAS f32x4* Pb = sP + (c & 1) * 1024;
        Pb[2 * tid] = p0; Pb[2 * tid + 1] = p1;
        const f32x2 ucur = uu;
        __syncthreads();
        if (c + 1 < NCHUNK) { const float* pn = PC + (size_t)((c + 1) * 32 + h) * 4096; p0 = ((const f32x4*)pn)[2 * tid]; p1 = ((const f32x4*)pn)[2 * tid + 1];
            uu = *(const f32x2*)(UC + (size_t)((c + 1) * 32 + h) * 4096 + (16 * rg + r) * 64 + 2 * jq); }
        const LAS float* Pf = (const LAS float*)Pb;
        float ax0 = ucur[0], ay0 = ucur[1], ax1 = 0.f, ay1 = 0.f;
#pragma unroll
        for (int mq = 0; mq < 16; ++mq) { const f32x4 s4 = *(const LAS f32x4*)(sS + r * 64 + 4 * mq);
            const f32x2 q0 = *(const LAS f32x2*)(Pf + (4 * mq) * 64 + 2 * jq), q1 = *(const LAS f32x2*)(Pf + (4 * mq + 1) * 64 + 2 * jq),
                        q2 = *(const LAS f32x2*)(Pf + (4 * mq + 2) * 64 + 2 * jq), q3 = *(const LAS f32x2*)(Pf + (4 * mq + 3) * 64 + 2 * jq);
            ax0 = fmaf(s4[0], q0[0], ax0); ay0 = fmaf(s4[0], q0[1], ay0); ax1 = fmaf(s4[1], q1[0], ax1); ay1 = fmaf(s4[1], q1[1], ay1);
            ax0 = fmaf(s4[2], q2[0], ax0); ay0 = fmaf(s4[2], q2[1], ay0); ax1 = fmaf(s4[3], q3[0], ax1); ay1 = fmaf(s4[3], q3[1], ay1); }
        const f32x2 sn = {ax0 + ax1, ay0 + ay1};
        __syncthreads();
        *(LAS f32x2*)(sS + r * 64 + 2 * jq) = sn;
        float* dst = (c + 1 < NCHUNK) ? SC + (size_t)((c + 1) * 32 + h) * 4096 : X.out + O_RWP + (size_t)h * 4096;
        *(f32x2*)(dst + (16 * rg + r) * 64 + 2 * jq) = sn;
    }
    __syncthreads();
}

__device__ __forceinline__ void phase_scan_c(const Ctx& X) {
    LAS float* wl = (LAS float*)(X.lds + X.wave * SCAN_WLDS);
    const float* SC = X.W<float>(WS_SC); const float* BON = X.W<float>(WS_BON); const bf16_t* GG = X.W<bf16_t>(WS_GG); bf16_t* OC = X.W<bf16_t>(WS_OCAT);
    const int lane = X.lane;
    for (int id = X.bid * 8 + X.wave; id < NCHUNK * 32 + DEC_B * 32; id += X.G * 8) {
        const bool smp = id >= NCHUNK * 32; const int task = smp ? id - NCHUNK * 32 : id, cb = task >> 5, h = task & 31;
        const int tok0 = smp ? SEQ + cb * 8 : cb * CHUNK, nsb = smp ? 1 : CHUNK / 8;
        float S[64];
        const float* s0 = smp ? X.in[I_SRW] + ((size_t)(cb * 32 + h) * 64 + lane) * 64 : SC + ((size_t)(cb * 32 + h) * 64 + lane) * 64;
        if (smp || cb > 0) {
#pragma unroll
            for (int q = 0; q < 16; ++q) { const f32x4 v = *(const f32x4*)(s0 + 4 * q); S[4 * q] = v[0]; S[4 * q + 1] = v[1]; S[4 * q + 2] = v[2]; S[4 * q + 3] = v[3]; }
        } else {
#pragma unroll
            for (int j = 0; j < 64; ++j) S[j] = 0.f; }
        const float lw = X.in[I_LNW][h * 64 + lane], lb = X.in[I_LNB][h * 64 + lane];
        ScanRegs R; scan_load(X, R, tok0, h, lane, true, true);
        for (int sb = 0; sb < nsb; ++sb) {
            scan_store(wl, R, lane, true, true);
            wave_sync();
            if (sb + 1 < nsb) scan_load(X, R, tok0 + 8 * (sb + 1), h, lane, true, true);
#pragma unroll 1
            for (int s = 0; s < 8; ++s) {
                const int t = tok0 + 8 * sb + s;
                const float g = bf2f(GG[(size_t)t * DM + h * 64 + lane]); const float bon = BON[(size_t)t * 32 + h];
                const float o = scan_step<true, true>(S, wl + s * 384, lane);
                const float mean = wave_sum(o) * (1.f / 64.f), d = o - mean, var = wave_sum(d * d) * (1.f / 64.f);
                const float on = d * rsqrtf(var + 64e-5f) * lw + lb;
                const float vi = wl[s * 384 + 320 + lane];
                OC[(size_t)t * 4096 + h * 64 + lane] = f2bf((on + bon * vi) * g);
            }
            wave_sync();
        }
        if (smp) { float* dst = X.out + O_RWS + ((size_t)(cb * 32 + h) * 64 + lane) * 64;
#pragma unroll
            for (int q = 0; q < 16; ++q) *(f32x4*)(dst + 4 * q) = (f32x4){S[4 * q], S[4 * q + 1], S[4 * q + 2], S[4 * q + 3]}; }
    }
}

__device__ __forceinline__ unsigned okey(float f) { const unsigned u = __float_as_uint(f); return (u & 0x80000000u) ? ~u : (u | 0x80000000u); }
constexpr int IDX_HIST = 131072, IDX_MISC = IDX_HIST + 8192;
template <int NQ, bool SAMPLE>
__device__ __forceinline__ void indexer_task(const Ctx& X, int task) {
    constexpr int SCLD = SAMPLE ? 2064 : 8192, WPQ = 8 / NQ, TPQ = 64 * WPQ;
    const int tid = X.tid, lane = X.lane, wave = X.wave, fr = lane & 15, fq = lane >> 4;
    const bf16_t* Z = X.W<bf16_t>(WS_Z); const bf16_t* KIB = X.W<bf16_t>(WS_KIB); const float* WI = X.W<float>(WS_WI);
    LAS float* sc = (LAS float*)X.lds;
    const int tokbase = SAMPLE ? SEQ + task * 8 : task * 4;
    bf16x8 Af[NQ][2]; float wq[NQ][4];
#pragma unroll
    for (int qq = 0; qq < NQ; ++qq) { const bf16_t* zq = Z + (size_t)(tokbase + qq) * ZLD + C_QI + fr * 64 + fq * 8;
        Af[qq][0] = *(const bf16x8*)zq; Af[qq][1] = *(const bf16x8*)(zq + 32);
#pragma unroll
        for (int j = 0; j < 4; ++j) wq[qq][j] = WI[(size_t)(tokbase + qq) * 16 + 4 * fq + j]; }
    const int nkeys = SAMPLE ? PAST + 8 : tokbase + 4, nkt = (nkeys + 15) >> 4;
    for (int kt = wave; kt < nkt; kt += 8) {
        const int key = kt * 16 + fr;
        bf16x8 b0, b1;
        if (!SAMPLE || key >= PAST) {
            const int krow = SAMPLE ? SEQ + task * 8 + (key - PAST) : key;
            if (!SAMPLE || key < PAST + 8) { const bf16_t* kr = KIB + (size_t)krow * 64 + fq * 8; b0 = *(const bf16x8*)kr; b1 = *(const bf16x8*)(kr + 32); }
            else { b0 = (bf16x8){0, 0, 0, 0, 0, 0, 0, 0}; b1 = b0; }
        } else {
            const int page = ((const int*)X.in[I_PT])[task * NPAGES + (key >> 7)];
            const float* kr = X.in[I_CKI] + ((size_t)page * PAGE + (key & 127)) * 64 + fq * 8;
            const f32x4 x0 = *(const f32x4*)kr, x1 = *(const f32x4*)(kr + 4), y0 = *(const f32x4*)(kr + 32), y1 = *(const f32x4*)(kr + 36);
            u32x4 w0, w1; w0.x = cvt_pk_bf16(x0[0], x0[1]); w0.y = cvt_pk_bf16(x0[2], x0[3]); w0.z = cvt_pk_bf16(x1[0], x1[1]); w0.w = cvt_pk_bf16(x1[2], x1[3]);
            w1.x = cvt_pk_bf16(y0[0], y0[1]); w1.y = cvt_pk_bf16(y0[2], y0[3]); w1.z = cvt_pk_bf16(y1[0], y1[1]); w1.w = cvt_pk_bf16(y1[2], y1[3]);
            b0 = __builtin_bit_cast(bf16x8, w0); b1 = __builtin_bit_cast(bf16x8, w1);
        }
#pragma unroll
        for (int qq = 0; qq < NQ; ++qq) {
            f32x4 acc = {0.f, 0.f, 0.f, 0.f};
            acc = __builtin_amdgcn_mfma_f32_16x16x32_bf16(Af[qq][0], b0, acc, 0, 0, 0);
            acc = __builtin_amdgcn_mfma_f32_16x16x32_bf16(Af[qq][1], b1, acc, 0, 0, 0);
            float s = wq[qq][0] * fmaxf(acc[0], 0.f) + wq[qq][1] * fmaxf(acc[1], 0.f) + wq[qq][2] * fmaxf(acc[2], 0.f) + wq[qq][3] * fmaxf(acc[3], 0.f);
            s += __shfl_xor(s, 16); s += __shfl_xor(s, 32);
            const int lim = SAMPLE ? PAST + qq : tokbase + qq;
            if (fq == 0 && key <= lim) sc[qq * SCLD + key] = s;
        }
    }
    __syncthreads();
    const int qq = wave / WPQ, qt = tid - qq * TPQ;
    const int n = SAMPLE ? PAST + 1 + qq : tokbase + qq + 1;
    const int nsel = n < 256 ? n : 256;
    LAS unsigned* hist = (LAS unsigned*)(X.lds + IDX_HIST) + qq * 256;
    LAS unsigned* misc = (LAS unsigned*)(X.lds + IDX_MISC) + qq * 4;
    const LAS float* scq = sc + qq * SCLD;
    unsigned prefix = 0u, kneed = (unsigned)nsel;
#pragma unroll 1
    for (int pass = 0; pass < 4; ++pass) {
        const int shift = 24 - 8 * pass;
        for (int i = qt; i < 256; i += TPQ) hist[i] = 0u;
        __syncthreads();
        for (int i = qt; i < n; i += TPQ) { const unsigned u = okey(scq[i]);
            const bool match = (pass == 0) ? true : ((u >> (shift + 8)) == (prefix >> (shift + 8)));
            if (match) __hip_atomic_fetch_add(&hist[(u >> shift) & 255u], 1u, __ATOMIC_RELAXED, __HIP_MEMORY_SCOPE_WORKGROUP); }
        __syncthreads();
        if (qt < 64) {
            const unsigned c0 = hist[255 - 4 * lane], c1 = hist[254 - 4 * lane], c2 = hist[253 - 4 * lane], c3 = hist[252 - 4 * lane];
            const unsigned tot = c0 + c1 + c2 + c3; unsigned incl = tot;
#pragma unroll
            for (int d = 1; d < 64; d <<= 1) { const unsigned v = __shfl_up(incl, d); if (lane >= d) incl += v; }
            const unsigned long long m = __ballot(incl >= kneed);
            const int L = m ? (__ffsll((long long)m) - 1) : 63;
            if (lane == L) { unsigned above = incl - tot; int bin;
                if (above + c0 >= kneed) bin = 255 - 4 * lane; else { above += c0;
                if (above + c1 >= kneed) bin = 254 - 4 * lane; else { above += c1;
                if (above + c2 >= kneed) bin = 253 - 4 * lane; else { above += c2; bin = 252 - 4 * lane; } } }
                misc[0] = prefix | ((unsigned)bin << shift); misc[1] = kneed - above; }
        }
        __syncthreads();
        prefix = misc[0]; kneed = misc[1];
    }
    if (qt == 0) { misc[2] = 0u; misc[3] = 0u; }
    __syncthreads();
    int* idxo = X.W<int>(WS_IDX) + (size_t)(tokbase + qq) * 256;
    for (int i = qt; i < n; i += TPQ) { const unsigned u = okey(scq[i]);
        if (u > prefix) { const unsigned p = __hip_atomic_fetch_add(&misc[2], 1u, __ATOMIC_RELAXED, __HIP_MEMORY_SCOPE_WORKGROUP); if (p < 256u) idxo[p] = i; }
        else if (u == prefix) { const unsigned e = __hip_atomic_fetch_add(&misc[3], 1u, __ATOMIC_RELAXED, __HIP_MEMORY_SCOPE_WORKGROUP); if (e < kneed) idxo[nsel - 1 - (int)e] = i; } }
    if (qt == 0) X.W<int>(WS_NSEL)[tokbase + qq] = nsel;
    __syncthreads();
}
__device__ __forceinline__ void phase_index(const Ctx& X) {
    const int npr = SEQ / 4;
    for (int i = 0; i * X.G + X.bid < npr; ++i) { const int k = (i >> 1) * X.G + X.bid; int task = (i & 1) ? npr - 1 - k : k;
        if (npr % (2 * X.G) != 0) task = i * X.G + X.bid;
        indexer_task<4, false>(X, task); }
    for (int task = X.bid; task < DEC_B; task += X.G) indexer_task<8, true>(X, task);
}

constexpr int ATT_WLDS = 4096 + 4096 + 1024;
template <bool SAMPLE>
__device__ __forceinline__ void attn_task(const Ctx& X, int t, int n) {
    const int lane = X.lane, fr = lane & 15, fq = lane >> 4;
    LAS float* lg = (LAS float*)(X.lds + X.wave * ATT_WLDS);
    LAS float* pT = lg + 1024;
    LAS int* lidx = (LAS int*)(pT + 1024);
    const bf16_t* QB = X.W<bf16_t>(WS_QB); const bf16_t* KB = X.W<bf16_t>(WS_KB); const bf16_t* VB = X.W<bf16_t>(WS_VB);
    const int ns = X.W<int>(WS_NSEL)[t];
    const int* idxg = X.W<int>(WS_IDX) + (size_t)t * 256;
#pragma unroll
    for (int i = 0; i < 4; ++i) { const int s = lane + 64 * i; lidx[s] = (s < ns) ? idxg[s] : 0; }
    const int b = SAMPLE ? (t - SEQ) >> 3 : 0;
    const int* pt = (const int*)X.in[I_PT] + b * NPAGES;
    bf16x8 Aq[4];
#pragma unroll
    for (int ks = 0; ks < 4; ++ks) { if (fr < 4) Aq[ks] = *(const bf16x8*)(QB + (size_t)t * DM + (4 * n + fr) * 128 + ks * 32 + fq * 8); else Aq[ks] = (bf16x8){0, 0, 0, 0, 0, 0, 0, 0}; }
    wave_sync();
    const int ntile = (ns + 15) >> 4;
    for (int kt = 0; kt < ntile; ++kt) {
        const int s = kt * 16 + fr, pos = lidx[s];
        f32x4 acc = {0.f, 0.f, 0.f, 0.f};
        bf16x8 Bk[4];
        if (!SAMPLE || pos >= PAST) {
            const int row = SAMPLE ? SEQ + b * 8 + (pos - PAST) : pos;
            const bf16_t* kr = KB + (size_t)row * 512 + n * 128 + fq * 8;
#pragma unroll
            for (int ks = 0; ks < 4; ++ks) Bk[ks] = *(const bf16x8*)(kr + ks * 32);
        } else {
            const float* kr = X.in[I_CK] + ((size_t)pt[pos >> 7] * PAGE + (pos & 127)) * 512 + n * 128 + fq * 8;
#pragma unroll
            for (int ks = 0; ks < 4; ++ks) { const f32x4 x0 = *(const f32x4*)(kr + ks * 32), x1 = *(const f32x4*)(kr + ks * 32 + 4);
                u32x4 w; w.x = cvt_pk_bf16(x0[0], x0[1]); w.y = cvt_pk_bf16(x0[2], x0[3]); w.z = cvt_pk_bf16(x1[0], x1[1]); w.w = cvt_pk_bf16(x1[2], x1[3]);
                Bk[ks] = __builtin_bit_cast(bf16x8, w); }
        }
#pragma unroll
        for (int ks = 0; ks < 4; ++ks) acc = __builtin_amdgcn_mfma_f32_16x16x32_bf16(Aq[ks], Bk[ks], acc, 0, 0, 0);
        if (fq == 0) {
#pragma unroll
            for (int j = 0; j < 4; ++j) lg[j * 256 + s] = acc[j]; }
    }
    wave_sync();
    {
        float l[16], m = -1e30f;
#pragma unroll
        for (int i = 0; i < 16; ++i) { const int s = fr * 16 + i; l[i] = (s < ns) ? lg[fq * 256 + s] : -1e30f; m = fmaxf(m, l[i]); }
        m = row16_max(m);
        float sum = 0.f;
#pragma unroll
        for (int i = 0; i < 16; ++i) { const int s = fr * 16 + i; const float e = (s < ns) ? __expf(l[i] - m) : 0.f; l[i] = e; sum += e; }
        sum = row16_sum(sum); const float inv = 1.f / sum;
#pragma unroll
        for (int i = 0; i < 16; ++i) pT[(fr * 16 + i) * 4 + fq] = l[i] * inv;
    }
    wave_sync();
    float acc[4][8];
#pragma unroll
    for (int hh = 0; hh < 4; ++hh)
#pragma unroll
        for (int d = 0; d < 8; ++d) acc[hh][d] = 0.f;
    const int nit = (ns + 3) >> 2;
    for (int it = 0; it < nit; ++it) {
        const int s = it * 4 + fq;
        if (s < ns) {
            const int pos = lidx[s]; float v[8];
            if (!SAMPLE || pos >= PAST) { const int row = SAMPLE ? SEQ + b * 8 + (pos - PAST) : pos; unpack8(*(const u32x4*)(VB + (size_t)row * 512 + n * 128 + fr * 8), v); }
            else { const float* vr = X.in[I_CV] + ((size_t)pt[pos >> 7] * PAGE + (pos & 127)) * 512 + n * 128 + fr * 8; const f32x4 x0 = *(const f32x4*)vr, x1 = *(const f32x4*)(vr + 4);
                v[0] = x0[0]; v[1] = x0[1]; v[2] = x0[2]; v[3] = x0[3]; v[4] = x1[0]; v[5] = x1[1]; v[6] = x1[2]; v[7] = x1[3]; }
            const f32x4 p4 = *(const LAS f32x4*)(pT + s * 4);
#pragma unroll
            for (int hh = 0; hh < 4; ++hh)
#pragma unroll
                for (int d = 0; d < 8; ++d) acc[hh][d] = fmaf(p4[hh], v[d], acc[hh][d]);
        }
    }
#pragma unroll
    for (int hh = 0; hh < 4; ++hh)
#pragma unroll
        for (int d = 0; d < 8; ++d) { float a = acc[hh][d]; a += __shfl_xor(a, 16); a += __shfl_xor(a, 32); acc[hh][d] = a; }
    if (fq == 0) { bf16_t* op = X.W<bf16_t>(WS_OCAT) + (size_t)t * 4096 + 2048 + (4 * n) * 128 + fr * 8;
#pragma unroll
        for (int hh = 0; hh < 4; ++hh) *(u32x4*)(op + hh * 128) = pack8(acc[hh]); }
    wave_sync();
}
__device__ __forceinline__ void phase_attn(const Ctx& X) {
    if (X.G % 4 == 0) {
        const int n = X.bid & 3, tstep = (X.G >> 2) * 8;
        for (int t = (X.bid >> 2) * 8 + X.wave; t < NTOK; t += tstep) { if (t < SEQ) attn_task<false>(X, t, n); else attn_task<true>(X, t, n); }
    } else {
        for (int id = X.bid * 8 + X.wave; id < NTOK * 4; id += X.G * 8) { const int t = id >> 2, n = id & 3; if (t < SEQ) attn_task<false>(X, t, n); else attn_task<true>(X, t, n); }
    }
}

__device__ __forceinline__ void phase_conv_act(const Ctx& X) {
    const bf16_t* U = X.W<bf16_t>(WS_U); bf16_t* ACT = X.W<bf16_t>(WS_ACT);
    const float* cw = X.in[I_CW]; const float* cb = X.in[I_CB];
    constexpr int PER = DFF / 8;
    for (int item = X.bid * 512 + X.tid; item < NTOK * PER; item += X.G * 512) {
        const int t = item / PER, f8 = (item - t * PER) * 8;
        const bool smp = t >= SEQ; const int tt = smp ? t - SEQ : t; const int p = smp ? (tt & 7) : t; const int b = tt >> 3;
        const bf16_t* ur = U + (size_t)t * UPN;
        float u0[8], uv[8], m1[8], m2[8];
        unpack8(*(const u32x4*)(ur + f8), u0); unpack8(*(const u32x4*)(ur + DFF + f8), uv);
        const float* cprev = X.in[I_SCV] + (size_t)b * 2 * DFF;
        if (p >= 1) unpack8(*(const u32x4*)(ur - UPN + f8), m1);
        else {
#pragma unroll
            for (int j = 0; j < 8; ++j) m1[j] = smp ? cprev[DFF + f8 + j] : 0.f; }
        if (p >= 2) unpack8(*(const u32x4*)(ur - 2 * UPN + f8), m2);
        else {
#pragma unroll
            for (int j = 0; j < 8; ++j) m2[j] = smp ? cprev[p * DFF + f8 + j] : 0.f; }
        float o[8];
#pragma unroll
        for (int j = 0; j < 8; ++j) { const float a = cb[f8 + j] + cw[f8 + j] * m2[j] + cw[DFF + f8 + j] * m1[j] + cw[2 * DFF + f8 + j] * u0[j];
            o[j] = a * sigmoidf_(a) * uv[j]; }
        *(u32x4*)(ACT + (size_t)t * DFF + f8) = pack8(o);
        float* co = nullptr;
        if (!smp && t >= SEQ - 2) co = X.out + O_CVP + (size_t)(t - (SEQ - 2)) * DFF + f8;
        if (smp && p >= 6) co = X.out + O_CVS + ((size_t)b * 2 + (p - 6)) * DFF + f8;
        if (co) { *(f32x4*)co = (f32x4){u0[0], u0[1], u0[2], u0[3]}; *(f32x4*)(co + 4) = (f32x4){u0[4], u0[5], u0[6], u0[7]}; }
    }
}

enum { PH_CONVERT = 0, PH_ADA, PH_NORM1, PH_GEMM1, PH_PREP1, PH_LORA, PH_LORA2, PH_LORA3, PH_PREP2, PH_SCAN_A, PH_SCAN_B, PH_SCAN_C, PH_INDEX, PH_ATTN, PH_PROJ, PH_OUT, PH_NORM2, PH_UP, PH_CONVACT, PH_DOWN, NPH };
#ifndef MK_N_LAUNCHES
#define MK_N_LAUNCHES 1
#endif
constexpr int CW_BAR = 1024;

struct Args { const float* in[36]; float* out; unsigned char* ws; int ph_lo, ph_hi; };
__device__ __forceinline__ void fresh(Ctx& X) { KTab t = X.in; asm volatile("" : "+s"(t)); X.in = t; X.lane = lane_id_fresh(); X.tid = X.wave * 64 + X.lane; }

__global__ void __launch_bounds__(512, 2) mega(Args a) {
    extern __shared__ __attribute__((aligned(16))) unsigned char lds_raw[];
    Ctx X;
    X.in = (KTab)__builtin_amdgcn_kernarg_segment_ptr();
    X.out = a.out; X.ws = a.ws; X.lds = (LAS unsigned char*)lds_raw;
    X.wave = __builtin_amdgcn_readfirstlane((int)threadIdx.x >> 6); X.lane = lane_id_fresh(); X.tid = X.wave * 64 + X.lane; X.G = gridDim.x; X.bid = blockIdx.x;
    const int lo = a.ph_lo, hi = a.ph_hi;
    const bool multi = (hi - lo) > 1;
    volatile LAS unsigned* MISC = (volatile LAS unsigned*)(X.lds + LDS_MISC);
    if (X.tid < 4) MISC[X.tid] = 0u;
    __syncthreads();
    XcdBarrier bar; bar.bar = X.W<unsigned>(WS_CTL) + CW_BAR; bar.x = 0; bar.st = MISC;
    if (multi) bar = xcd_barrier_post(X.W<unsigned>(WS_CTL) + CW_BAR, MISC);
#ifndef PHASE_MASK
#define PHASE_MASK 0xFFFFFFFFu
#endif
#define IN(k) (((PHASE_MASK >> (k)) & 1u) && (fresh(X), lo <= (k) && (k) < hi))
#define SEAM(k) do { if ((k) + 1 < hi) xcd_barrier(bar); } while (0)
    using namespace pg8;
    bf16_t* const Zb = X.W<bf16_t>(WS_Z); float* const MOD = X.W<float>(WS_MOD);

    if (IN(PH_CONVERT)) { phase_convert(X); SEAM(PH_CONVERT); }
    if (IN(PH_ADA)) {
        Gemm g{X.W<bf16_t>(WS_ASILU), X.W<bf16_t>(WS_WADA), 256, MODLD, DM, DM, DM}; StaticOrder S; S.init(256, MODLD, X.G, X.bid);
        EpiF32Bias E{MOD, MODLD, X.in[I_BADA]};
        gemm_phase<EpiF32Bias, StaticOrder, true, true>(X.lds, g, S, E, X.wave);
        SEAM(PH_ADA);
    }
    if (IN(PH_NORM1)) { phase_norm_mod(X, X.in[I_XP], X.in[I_XS], X.in[I_N1G], 0, 2048, X.W<bf16_t>(WS_H)); SEAM(PH_NORM1); }
    if (IN(PH_GEMM1)) {
        Gemm g{X.W<bf16_t>(WS_H), X.W<bf16_t>(WS_WIN), NTOK, ZLD, DM, DM, DM}; StaticOrder S; S.init(NTOK, ZLD, X.G, X.bid);
        EpiBf16<0> E{Zb, ZLD, nullptr};
        gemm_phase<EpiBf16<0>, StaticOrder, true, true>(X.lds, g, S, E, X.wave);
        SEAM(PH_GEMM1);
    }
    if (IN(PH_PREP1)) { phase_prep1(X); SEAM(PH_PREP1); }
    if (IN(PH_LORA)) {
        StaticOrder S; S.init(NTOK, DM, X.G, X.bid);
        Gemm g{X.W<bf16_t>(WS_ADEC), X.W<bf16_t>(WS_WDEC), NTOK, DM, 256, 256, 256}; EpiBf16<1> E{X.W<bf16_t>(WS_LW), DM, X.in[I_W0]};
        gemm_phase<EpiBf16<1>, StaticOrder, true, true>(X.lds, g, S, E, X.wave);
        SEAM(PH_LORA);
    }
    if (IN(PH_LORA2)) {
        StaticOrder S; S.init(NTOK, DM, X.G, X.bid);
        Gemm g{X.W<bf16_t>(WS_AAIN), X.W<bf16_t>(WS_WA), NTOK, DM, 256, 256, 256}; EpiBf16<2> E{X.W<bf16_t>(WS_AAO), DM, X.in[I_A0]};
        gemm_phase<EpiBf16<2>, StaticOrder, true, true>(X.lds, g, S, E, X.wave);
        SEAM(PH_LORA2);
    }
    if (IN(PH_LORA3)) {
        StaticOrder S; S.init(NTOK, DM, X.G, X.bid);
        Gemm g{X.W<bf16_t>(WS_AGIN), X.W<bf16_t>(WS_WG), NTOK, DM, 256, 256, 256}; EpiBf16<0> E{X.W<bf16_t>(WS_GG), DM, nullptr};
        gemm_phase<EpiBf16<0>, StaticOrder, true, true>(X.lds, g, S, E, X.wave);
        SEAM(PH_LORA3);
    }
    if (IN(PH_PREP2)) { phase_prep2(X); SEAM(PH_PREP2); }
    if (IN(PH_SCAN_A)) { phase_scan_a(X); SEAM(PH_SCAN_A); }
    if (IN(PH_SCAN_B)) { phase_scan_b(X); SEAM(PH_SCAN_B); }
    if (IN(PH_SCAN_C)) { phase_scan_c(X); SEAM(PH_SCAN_C); }
    if (IN(PH_INDEX)) { phase_index(X); SEAM(PH_INDEX); }
    if (IN(PH_ATTN)) { phase_attn(X); SEAM(PH_ATTN); }
    if (IN(PH_PROJ)) {
        StaticOrder S; S.init(NTOK, DM, X.G, X.bid);
        { Gemm g{X.W<bf16_t>(WS_OCAT), X.W<bf16_t>(WS_WPA), NTOK, DM, DM, 4096, 4096}; EpiProjA E{X.W<float>(WS_TMPA), Zb};
          gemm_phase<EpiProjA, StaticOrder, true, true>(X.lds, g, S, E, X.wave); }
        { Gemm g{X.W<bf16_t>(WS_OCAT) + 2048, X.W<bf16_t>(WS_WPA) + 2048, NTOK, DM, DM, 4096, 4096}; EpiProjB E{X.W<float>(WS_TMPA), Zb, X.W<bf16_t>(WS_MIX)};
          gemm_phase<EpiProjB, StaticOrder, true, true>(X.lds, g, S, E, X.wave); }
        SEAM(PH_PROJ);
    }
    if (IN(PH_OUT)) {
        Gemm g{X.W<bf16_t>(WS_MIX), X.W<bf16_t>(WS_WOUT), NTOK, DM, DM, DM, DM}; StaticOrder S; S.init(NTOK, DM, X.G, X.bid);
        EpiResidual E{X.in[I_XP], X.in[I_XS], MOD, 4096, X.W<float>(WS_XM)};
        gemm_phase<EpiResidual, StaticOrder, true, true>(X.lds, g, S, E, X.wave);
        SEAM(PH_OUT);
    }
    if (IN(PH_NORM2)) { phase_norm_mod(X, X.W<float>(WS_XM), X.W<float>(WS_XM) + (size_t)SEQ * DM, X.in[I_N2G], 6144, 8192, X.W<bf16_t>(WS_H)); SEAM(PH_NORM2); }
    if (IN(PH_UP)) {
        Gemm g{X.W<bf16_t>(WS_H), X.W<bf16_t>(WS_WUP), NTOK, UPN, DM, DM, DM}; StaticOrder S; S.init(NTOK, UPN, X.G, X.bid);
        EpiBf16<0> E{X.W<bf16_t>(WS_U), UPN, nullptr};
        gemm_phase<EpiBf16<0>, StaticOrder, true, true>(X.lds, g, S, E, X.wave);
        SEAM(PH_UP);
    }
    if (IN(PH_CONVACT)) { phase_conv_act(X); SEAM(PH_CONVACT); }
    if (IN(PH_DOWN)) {
        Gemm g{X.W<bf16_t>(WS_ACT), X.W<bf16_t>(WS_WDN), NTOK, DM, DFF, DFF, DFF}; StaticOrder S; S.init(NTOK, DM, X.G, X.bid);
        EpiResidual E{X.W<float>(WS_XM), X.W<float>(WS_XM) + (size_t)SEQ * DM, MOD, 10240, X.out + O_YP};
        gemm_phase<EpiResidual, StaticOrder, true, true>(X.lds, g, S, E, X.wave);
    }
#undef IN
#undef SEAM
}

extern "C" void kernel_launch(void* const* d_in, const int* in_sizes, int n_in, void* d_out, int out_size, void* d_ws, size_t ws_size, hipStream_t stream) {
    static int grid = 0;
    if (grid == 0) {
        if (n_in != 36 || (size_t)out_size != O_END || ws_size < WS_END) { fprintf(stderr, "kernel_launch: unexpected shapes: n_in %d out %d ws %zu (need %zu)\n", n_in, out_size, ws_size, (size_t)WS_END); grid = -1; return; }
        int dev = 0, cus = 0, per_cu = 0;
        if (hipGetDevice(&dev) != hipSuccess || hipDeviceGetAttribute(&cus, hipDeviceAttributeMultiprocessorCount, dev) != hipSuccess) { grid = -1; return; }
        if (hipFuncSetAttribute((const void*)mega, hipFuncAttributeMaxDynamicSharedMemorySize, LDS_BYTES) != hipSuccess) { fprintf(stderr, "kernel_launch: hipFuncSetAttribute failed\n"); grid = -1; return; }
        if (hipOccupancyMaxActiveBlocksPerMultiprocessor(&per_cu, (const void*)mega, 512, LDS_BYTES) != hipSuccess || per_cu < 1) fprintf(stderr, "kernel_launch: occupancy query says %d\n", per_cu);
        (void)hipGetLastError();
        grid = cus;
    }
    if (grid < 0) return;
    (void)hipMemsetAsync((char*)d_ws + WS_CTL, 0, CTL_BYTES, stream);
    Args a{};
    for (int i = 0; i < 36; ++i) a.in[i] = (const float*)d_in[i];
    a.out = (float*)d_out; a.ws = (unsigned char*)d_ws;
    constexpr int NL = MK_N_LAUNCHES;
    for (int li = 0; li < NL; ++li) {
        a.ph_lo = (NL == 1) ? 0 : li; a.ph_hi = (NL == 1) ? NPH : li + 1;
        hipLaunchKernelGGL(mega, dim3(grid), dim3(512), LDS_BYTES, stream, a);
        const hipError_t le = hipPeekAtLastError();
        if (le != hipSuccess) { fprintf(stderr, "kernel_launch: launch %d failed: %s\n", li, hipGetErrorName(le)); break; }
    }
}
```

```cpp
#include <hip/hip_runtime.h>
#include <cstdio>
#include <cstdint>

#define LAS __attribute__((address_space(3)))
typedef unsigned short bf16_t;
typedef short bf16x8 __attribute__((ext_vector_type(8)));
typedef float f32x4 __attribute__((ext_vector_type(4)));
typedef float f32x16 __attribute__((ext_vector_type(16)));
typedef float f32x2 __attribute__((ext_vector_type(2)));
typedef unsigned u32x4 __attribute__((ext_vector_type(4)));
typedef unsigned u32x2 __attribute__((ext_vector_type(2)));

constexpr int DM = 2048, SEQ = 8192, DEC_B = 128, DEC_T = 8, NTOK = SEQ + DEC_B * DEC_T;
constexpr int SHIFT_W = 6592, IN_COLS = 14864, ZLD = 15104;
constexpr int C_R = 0, C_K = 2048, C_V = 4096, C_WD = 6144, C_AD = 6240, C_GD = 6336;
constexpr int C_Q = 6592, C_KK = 8640, C_VV = 9152, C_QI = 9664, C_KI = 10688, C_WI = 10752, C_GA = 10768, C_GB = 12816;
constexpr int DFF = 5632, UPN = 11264, MODLD = 12288;
constexpr int NPAGES = 16, PAGE = 128, PAST = 2048;
constexpr int CHUNK = 128, NCHUNK = SEQ / CHUNK;

constexpr size_t O_YP = 0, O_YS = O_YP + (size_t)SEQ * DM, O_KP = O_YS + (size_t)1024 * DM, O_VP = O_KP + (size_t)SEQ * 512, O_KIP = O_VP + (size_t)SEQ * 512,
                 O_RWP = O_KIP + (size_t)SEQ * 64, O_SHP = O_RWP + 32 * 64 * 64, O_CVP = O_SHP + SHIFT_W, O_KS = O_CVP + 2 * DFF, O_VS = O_KS + 1024 * 512,
                 O_KIS = O_VS + 1024 * 512, O_RWS = O_KIS + 1024 * 64, O_SHS = O_RWS + (size_t)DEC_B * 32 * 64 * 64, O_CVS = O_SHS + (size_t)DEC_B * SHIFT_W,
                 O_END = O_CVS + (size_t)DEC_B * 2 * DFF;
static_assert(O_END == 48113088, "output size");

constexpr size_t al256(size_t x) { return (x + 255) & ~(size_t)255; }
constexpr size_t WS_CTL = 0, CTL_BYTES = 1u << 20;
constexpr size_t WS_WIN = al256(WS_CTL + CTL_BYTES);
constexpr size_t WS_WADA = al256(WS_WIN + (size_t)ZLD * DM * 2);
constexpr size_t WS_WPA = al256(WS_WADA + (size_t)MODLD * DM * 2);
constexpr size_t WS_WOUT = al256(WS_WPA + (size_t)DM * 4096 * 2);
constexpr size_t WS_WUP = al256(WS_WOUT + (size_t)DM * DM * 2);
constexpr size_t WS_WDN = al256(WS_WUP + (size_t)UPN * DM * 2);
constexpr size_t WS_WDEC = al256(WS_WDN + (size_t)DM * DFF * 2);
constexpr size_t WS_WA = al256(WS_WDEC + (size_t)DM * 256 * 2);
constexpr size_t WS_WG = al256(WS_WA + (size_t)DM * 256 * 2);
constexpr size_t WS_ASILU = al256(WS_WG + (size_t)DM * 256 * 2);
constexpr size_t WS_MOD = al256(WS_ASILU + (size_t)256 * DM * 2);
constexpr size_t WS_H = al256(WS_MOD + (size_t)256 * MODLD * 4);
constexpr size_t WS_Z = al256(WS_H + (size_t)NTOK * DM * 2);
constexpr size_t WS_ADEC = al256(WS_Z + (size_t)NTOK * ZLD * 2);
constexpr size_t WS_AAIN = al256(WS_ADEC + (size_t)NTOK * 256 * 2);
constexpr size_t WS_AGIN = al256(WS_AAIN + (size_t)NTOK * 256 * 2);
constexpr size_t WS_LW = al256(WS_AGIN + (size_t)NTOK * 256 * 2);
constexpr size_t WS_AAO = al256(WS_LW + (size_t)NTOK * DM * 2);
constexpr size_t WS_GG = al256(WS_AAO + (size_t)NTOK * DM * 2);
constexpr size_t WS_RS = al256(WS_GG + (size_t)NTOK * DM * 2);
constexpr size_t WS_KS = al256(WS_RS + (size_t)NTOK * DM * 2);
constexpr size_t WS_VS = al256(WS_KS + (size_t)NTOK * DM * 2);
constexpr size_t WS_AS = al256(WS_VS + (size_t)NTOK * DM * 2);
constexpr size_t WS_BS = al256(WS_AS + (size_t)NTOK * DM * 2);
constexpr size_t WS_BON = al256(WS_BS + (size_t)NTOK * DM * 2);
constexpr size_t WS_PC = al256(WS_BON + (size_t)NTOK * 32 * 4);
constexpr size_t WS_UC = al256(WS_PC + (size_t)NCHUNK * 32 * 4096 * 4);
constexpr size_t WS_SC = al256(WS_UC + (size_t)NCHUNK * 32 * 4096 * 4);
constexpr size_t WS_OCAT = al256(WS_SC + (size_t)NCHUNK * 32 * 4096 * 4);
constexpr size_t WS_QB = al256(WS_OCAT + (size_t)NTOK * 4096 * 2);
constexpr size_t WS_KB = al256(WS_QB + (size_t)NTOK * DM * 2);
constexpr size_t WS_VB = al256(WS_KB + (size_t)NTOK * 512 * 2);
constexpr size_t WS_KIB = al256(WS_VB + (size_t)NTOK * 512 * 2);
constexpr size_t WS_WI = al256(WS_KIB + (size_t)NTOK * 64 * 2);
constexpr size_t WS_IDX = al256(WS_WI + (size_t)NTOK * 16 * 4);
constexpr size_t WS_NSEL = al256(WS_IDX + (size_t)NTOK * 256 * 4);
constexpr size_t WS_TMPA = al256(WS_NSEL + (size_t)NTOK * 4);
constexpr size_t WS_MIX = al256(WS_TMPA + (size_t)NTOK * DM * 4);
constexpr size_t WS_XM = al256(WS_MIX + (size_t)NTOK * DM * 2);
constexpr size_t WS_U = al256(WS_XM + (size_t)NTOK * DM * 4);
constexpr size_t WS_ACT = al256(WS_U + (size_t)NTOK * UPN * 2);
constexpr size_t WS_PB = al256(WS_ACT + (size_t)NTOK * DFF * 2);
constexpr size_t WS_QV = al256(WS_PB + (size_t)NTOK * 4 * 1024 * 2);
constexpr size_t WS_UR = al256(WS_QV + (size_t)SEQ * DM * 2);
constexpr size_t WS_Q8 = al256(WS_UR + (size_t)SEQ * DM * 2);
constexpr size_t WS_K8 = al256(WS_Q8 + (size_t)SEQ * DM);
constexpr size_t WS_V8 = al256(WS_K8 + (size_t)SEQ * 512);
constexpr size_t WS_SLAB = al256(WS_V8 + (size_t)SEQ * 512);
constexpr size_t WS_END = al256(WS_SLAB + (size_t)640 * 262144);

constexpr int LDS_BYTES = 155648;
constexpr int LDS_MISC = 147456;

typedef __bf16 bf16x2_t __attribute__((ext_vector_type(2)));
__device__ __forceinline__ unsigned cvt_pk_bf16(float lo, float hi) { f32x2 v = {lo, hi}; bf16x2_t b = __builtin_convertvector(v, bf16x2_t); return __builtin_bit_cast(unsigned, b); }
__device__ __forceinline__ float bf_lo(unsigned w) { return __uint_as_float(w << 16); }
__device__ __forceinline__ float bf_hi(unsigned w) { return __uint_as_float(w & 0xffff0000u); }
__device__ __forceinline__ float bf2f(bf16_t b) { return __uint_as_float(((unsigned)b) << 16); }
__device__ __forceinline__ bf16_t f2bf(float f) { return (bf16_t)(cvt_pk_bf16(f, 0.f) & 0xffffu); }
__device__ __forceinline__ void unpack8(const u32x4 w, float (&f)[8]) {
    f[0] = bf_lo(w.x); f[1] = bf_hi(w.x); f[2] = bf_lo(w.y); f[3] = bf_hi(w.y); f[4] = bf_lo(w.z); f[5] = bf_hi(w.z); f[6] = bf_lo(w.w); f[7] = bf_hi(w.w); }
__device__ __forceinline__ u32x4 pack8(const float (&f)[8]) { u32x4 w; w.x = cvt_pk_bf16(f[0], f[1]); w.y = cvt_pk_bf16(f[2], f[3]); w.z = cvt_pk_bf16(f[4], f[5]); w.w = cvt_pk_bf16(f[6], f[7]); return w; }
template <int CTRL> __device__ __forceinline__ float dpp_f(float x) { return __builtin_bit_cast(float, __builtin_amdgcn_update_dpp(0, __builtin_bit_cast(int, x), CTRL, 0xf, 0xf, true)); }
__device__ __forceinline__ float row16_sum(float x) {
    x += dpp_f<0xB1>(x); x += dpp_f<0x4E>(x); x += dpp_f<0x141>(x); x += dpp_f<0x140>(x); return x; }
__device__ __forceinline__ float row16_max(float x) {
    x = fmaxf(x, dpp_f<0xB1>(x)); x = fmaxf(x, dpp_f<0x4E>(x)); x = fmaxf(x, dpp_f<0x141>(x)); x = fmaxf(x, dpp_f<0x140>(x)); return x; }
__device__ __forceinline__ float row8_sum(float x) { x += dpp_f<0xB1>(x); x += dpp_f<0x4E>(x); x += dpp_f<0x141>(x); return x; }
__device__ __forceinline__ float wave_sum(float x) {
    x = row16_sum(x);
    const float a = __builtin_bit_cast(float, __builtin_amdgcn_readlane(__builtin_bit_cast(int, x), 0)), b = __builtin_bit_cast(float, __builtin_amdgcn_readlane(__builtin_bit_cast(int, x), 16)),
                c = __builtin_bit_cast(float, __builtin_amdgcn_readlane(__builtin_bit_cast(int, x), 32)), d = __builtin_bit_cast(float, __builtin_amdgcn_readlane(__builtin_bit_cast(int, x), 48));
    return (a + b) + (c + d); }
__device__ __forceinline__ float rows4_sum(float x) {
    typedef unsigned u2_t __attribute__((ext_vector_type(2)));
    u2_t r = __builtin_amdgcn_permlane16_swap(__builtin_bit_cast(unsigned, x), __builtin_bit_cast(unsigned, x), false, false);
    const float t = __builtin_bit_cast(float, r.x) + __builtin_bit_cast(float, r.y);
    u2_t q = __builtin_amdgcn_permlane32_swap(__builtin_bit_cast(unsigned, t), __builtin_bit_cast(unsigned, t), false, false);
    return __builtin_bit_cast(float, q.x) + __builtin_bit_cast(float, q.y); }
__device__ __forceinline__ float sigmoidf_(float x) { return __builtin_amdgcn_rcpf(1.f + __expf(-x)); }
__device__ __forceinline__ int lane_id_fresh() { int l; asm volatile("v_mbcnt_lo_u32_b32 %0, -1, 0\n\tv_mbcnt_hi_u32_b32 %0, -1, %0" : "=v"(l)); return l; }
__device__ __forceinline__ u32x2 pack8_fp8(const float (&f)[8]) { int a = 0, b = 0;
    a = __builtin_amdgcn_cvt_pk_fp8_f32(f[0], f[1], a, false); a = __builtin_amdgcn_cvt_pk_fp8_f32(f[2], f[3], a, true);
    b = __builtin_amdgcn_cvt_pk_fp8_f32(f[4], f[5], b, false); b = __builtin_amdgcn_cvt_pk_fp8_f32(f[6], f[7], b, true);
    u32x2 r; r.x = (unsigned)a; r.y = (unsigned)b; return r; }
__device__ __forceinline__ void unpack8_fp8(const u32x2 w, float (&f)[8]) {
    const f32x2 a = __builtin_amdgcn_cvt_pk_f32_fp8((int)w.x, false), b = __builtin_amdgcn_cvt_pk_f32_fp8((int)w.x, true), c = __builtin_amdgcn_cvt_pk_f32_fp8((int)w.y, false), d = __builtin_amdgcn_cvt_pk_f32_fp8((int)w.y, true);
    f[0] = a[0]; f[1] = a[1]; f[2] = b[0]; f[3] = b[1]; f[4] = c[0]; f[5] = c[1]; f[6] = d[0]; f[7] = d[1]; }
__device__ __forceinline__ void wave_sync() { asm volatile("s_waitcnt lgkmcnt(0)" ::: "memory"); __builtin_amdgcn_wave_barrier(); asm volatile("" ::: "memory"); }

namespace pg8 {
#define PG8_LAS __attribute__((address_space(3)))
constexpr int BM = 256, BK = 64, HALF = 128, HTB = HALF * BK * 2  , STAGE_BYTES = 8 * HTB, NXCD = 8, WGM = 8;

__host__ __device__ __forceinline__ int lds_byte(int r, int c) { const int st = (r >> 4) * 2 + (c >> 5), rr = r & 15, cc = c & 31, ob = rr * 64 + cc * 2; return st * 1024 + (ob ^ (((ob >> 9) & 1) << 5)); }
__host__ __device__ __forceinline__ void stage_rc(int b, int& R, int& C) { const int st = b / 1024, sb = b % 1024, swz = sb ^ (((sb >> 9) & 1) << 5); R = (st >> 1) * 16 + swz / 64; C = (st & 1) * 32 + (swz % 64) / 2; }
__host__ __device__ __forceinline__ int perm32(int rho) { const int n = rho >> 4, i = rho & 15; return 8 * (i >> 2) + 4 * n + (i & 3); }

struct Unit { int pm, pn, kofs, q, p, nh; };
struct Gemm { const bf16_t* A; const bf16_t* Bt; int M, N, K, lda, ldb; };

struct StaticOrder {
    int nM, nN, nwg, G, c, limit, halves;
    __host__ __device__ void init(int M, int N, int G_, int c_) { nM = M / BM; nN = N / BM; nwg = nM * nN; G = G_; c = c_; limit = nwg; halves = 0; }
    __host__ __device__ void split_tail() { if (nwg % G) { limit = (nwg / G) * G; halves = 1; } }
    __host__ __device__ void tile_of(int L, Unit& u) const {
        int wgid = L; { const int q = nwg / NXCD, r = nwg % NXCD, xcd = wgid % NXCD, off = wgid / NXCD; wgid = (xcd < r ? xcd * (q + 1) : r * (q + 1) + (xcd - r) * q) + off; }
        const int nig = WGM * nN, gid = wgid / nig, fm = gid * WGM, gsz = (nM - fm) < WGM ? (nM - fm) : WGM;
        u.pm = fm + ((wgid % nig) % gsz); u.pn = (wgid % nig) / gsz; }
    __host__ __device__ bool next(int i, Unit& u) const {
        const long L = (long)i * G + c; u.kofs = 0; u.q = 0; u.p = 0; u.nh = -1;
        if (L < limit) { tile_of((int)L, u); return true; }
        if (!halves) return false;
        const long t = L - limit; if (t >= 2L * (nwg - limit)) return false;
        tile_of(limit + (int)(t >> 1), u); u.nh = (int)(t & 1); return true;
    }
    __device__ __forceinline__ void a_ready(const Unit&) const {}
    __device__ __forceinline__ void done(const Unit&) const {}
};
struct TailOrder : StaticOrder {
    int base, s, kpart;
    __host__ __device__ void init_tail(int M, int N, int G_, int c_, int s_, int kpart_) { init(M, N, G_, c_); base = (nwg / G) * G; s = s_; kpart = kpart_; }
    __host__ __device__ bool next(int i, Unit& u) const {
        const int j = i * G + c; if (j >= (nwg - base) * s) return false;
        u.q = j / s; u.p = j - u.q * s; tile_of(base + u.q, u); u.kofs = u.p * kpart; u.nh = -1; return true;
    }
};


typedef f32x4 AccT[2][2][4][2];
__device__ __forceinline__ int mod_row(int r) { return r < SEQ ? 0 : 1 + ((r - SEQ) >> 3); }

struct EpiF32Bias {
    static constexpr bool PERM = false, AFTER_DRAIN = false;
    float* C; int ldc; const float* bias;
    __device__ __forceinline__ void operator()(const AccT& acc, const Unit& u, int wr, int wc, int fr, int fq) const {
        const int row0 = u.pm * BM + wr * 64 + fr, col0 = u.pn * BM + wc * 32 + 4 * fq;
        f32x4 bv[2][2];
#pragma unroll
        for (int bj = 0; bj < 2; ++bj)
#pragma unroll
            for (int n = 0; n < 2; ++n) bv[bj][n] = *(const f32x4*)(bias + col0 + bj * HALF + n * 16);
#pragma unroll
        for (int ai = 0; ai < 2; ++ai)
#pragma unroll
            for (int m = 0; m < 4; ++m) { float* rowp = C + (size_t)(row0 + ai * HALF + m * 16) * ldc + col0;
#pragma unroll
                for (int bj = 0; bj < 2; ++bj)
#pragma unroll
                    for (int n = 0; n < 2; ++n) *(f32x4*)(rowp + bj * HALF + n * 16) = acc[ai][bj][m][n] + bv[bj][n]; }
    }
};
template <int MODE> struct EpiBf16 {
    static constexpr bool PERM = true, AFTER_DRAIN = false;
    bf16_t* O; int ldc; const float* p;
    __device__ __forceinline__ void operator()(const AccT& acc, const Unit& u, int wr, int wc, int fr, int fq) const {
        const int row0 = u.pm * BM + wr * 64 + fr, col0 = u.pn * BM + wc * 32 + 8 * fq;
#pragma unroll
        for (int bj = 0; bj < 2; ++bj) { if (u.nh >= 0 && bj != u.nh) continue;
            f32x4 pv0 = {0.f, 0.f, 0.f, 0.f}, pv1 = pv0;
            if (MODE) { pv0 = *(const f32x4*)(p + col0 + bj * HALF); pv1 = *(const f32x4*)(p + col0 + bj * HALF + 4); }
#pragma unroll
            for (int ai = 0; ai < 2; ++ai)
#pragma unroll
                for (int m = 0; m < 4; ++m) { bf16_t* rowp = O + (size_t)(row0 + ai * HALF + m * 16) * ldc + col0;
                    f32x4 v0 = acc[ai][bj][m][0] + pv0, v1 = acc[ai][bj][m][1] + pv1;
                    if (MODE == 1 || MODE == 2) {
                        const float sc = (MODE == 1) ? -0.60653065971f : 1.f;
#pragma unroll
                        for (int e = 0; e < 4; ++e) { v0[e] = sc * sigmoidf_(v0[e]); v1[e] = sc * sigmoidf_(v1[e]); }
                    }
                    u32x4 w; w.x = cvt_pk_bf16(v0[0], v0[1]); w.y = cvt_pk_bf16(v0[2], v0[3]); w.z = cvt_pk_bf16(v1[0], v1[1]); w.w = cvt_pk_bf16(v1[2], v1[3]);
                    *(u32x4*)(rowp + bj * HALF) = w; }
        }
    }
};
struct EpiProjA {
    static constexpr bool PERM = false, AFTER_DRAIN = false;
    bf16_t* T; const bf16_t* Z;
    __device__ __forceinline__ void operator()(const AccT& acc, const Unit& u, int wr, int wc, int fr, int fq) const {
        const int row0 = u.pm * BM + wr * 64 + fr, col0 = u.pn * BM + wc * 32 + 4 * fq;
#pragma unroll
        for (int ai = 0; ai < 2; ++ai)
#pragma unroll
            for (int m = 0; m < 4; ++m) { const int r = row0 + ai * HALF + m * 16; bf16_t* rowp = T + (size_t)r * DM + col0; const bf16_t* zp = Z + (size_t)r * ZLD + C_GA + col0;
#pragma unroll
                for (int bj = 0; bj < 2; ++bj) if (u.nh < 0 || bj == u.nh)
#pragma unroll
                    for (int n = 0; n < 2; ++n) { const u32x2 gz = *(const u32x2*)(zp + bj * HALF + n * 16); f32x4 a = acc[ai][bj][m][n];
                        a[0] *= sigmoidf_(bf_lo(gz.x)); a[1] *= sigmoidf_(bf_hi(gz.x)); a[2] *= sigmoidf_(bf_lo(gz.y)); a[3] *= sigmoidf_(bf_hi(gz.y));
                        u32x2 w; w.x = cvt_pk_bf16(a[0], a[1]); w.y = cvt_pk_bf16(a[2], a[3]); *(u32x2*)(rowp + bj * HALF + n * 16) = w; } }
    }
};
struct EpiProjB {
    static constexpr bool PERM = true, AFTER_DRAIN = false;
    const bf16_t* T; const bf16_t* Z; bf16_t* O;
    __device__ __forceinline__ void operator()(const AccT& acc, const Unit& u, int wr, int wc, int fr, int fq) const {
        const int row0 = u.pm * BM + wr * 64 + fr, col0 = u.pn * BM + wc * 32 + 8 * fq;
#pragma unroll
        for (int ai = 0; ai < 2; ++ai)
#pragma unroll
            for (int m = 0; m < 4; ++m) { const int r = row0 + ai * HALF + m * 16; const bf16_t* tp = T + (size_t)r * DM + col0; const bf16_t* zp = Z + (size_t)r * ZLD + C_GB + col0; bf16_t* op = O + (size_t)r * DM + col0;
#pragma unroll
                for (int bj = 0; bj < 2; ++bj) { if (u.nh >= 0 && bj != u.nh) continue; const u32x4 gz = *(const u32x4*)(zp + bj * HALF); const u32x4 tw = *(const u32x4*)(tp + bj * HALF); const f32x4 t0 = {bf_lo(tw.x), bf_hi(tw.x), bf_lo(tw.y), bf_hi(tw.y)}, t1 = {bf_lo(tw.z), bf_hi(tw.z), bf_lo(tw.w), bf_hi(tw.w)};
                    const f32x4 a0 = acc[ai][bj][m][0], a1 = acc[ai][bj][m][1]; float o[8];
                    o[0] = t0[0] + sigmoidf_(bf_lo(gz.x)) * a0[0]; o[1] = t0[1] + sigmoidf_(bf_hi(gz.x)) * a0[1]; o[2] = t0[2] + sigmoidf_(bf_lo(gz.y)) * a0[2]; o[3] = t0[3] + sigmoidf_(bf_hi(gz.y)) * a0[3];
                    o[4] = t1[0] + sigmoidf_(bf_lo(gz.z)) * a1[0]; o[5] = t1[1] + sigmoidf_(bf_hi(gz.z)) * a1[1]; o[6] = t1[2] + sigmoidf_(bf_lo(gz.w)) * a1[2]; o[7] = t1[3] + sigmoidf_(bf_hi(gz.w)) * a1[3];
                    *(u32x4*)(op + bj * HALF) = pack8(o); } }
    }
};
struct EpiResidual {
    static constexpr bool PERM = false, AFTER_DRAIN = false;
    const float* res_p; const float* res_s; const float* MOD; int goff; float* OUT;
    __device__ __forceinline__ void operator()(const AccT& acc, const Unit& u, int wr, int wc, int fr, int fq) const {
        const int row0 = u.pm * BM + wr * 64 + fr, col0 = u.pn * BM + wc * 32 + 4 * fq;
#pragma unroll
        for (int ai = 0; ai < 2; ++ai)
#pragma unroll
            for (int m = 0; m < 4; ++m) { const int r = row0 + ai * HALF + m * 16;
                const float* rp = (r < SEQ ? res_p + (size_t)r * DM : res_s + (size_t)(r - SEQ) * DM) + col0;
                const float* gp = MOD + (size_t)mod_row(r) * MODLD + goff + col0; float* op = OUT + (size_t)r * DM + col0;
#pragma unroll
                for (int bj = 0; bj < 2; ++bj) if (u.nh < 0 || bj == u.nh)
#pragma unroll
                    for (int n = 0; n < 2; ++n) { const f32x4 x = *(const f32x4*)(rp + bj * HALF + n * 16), g = *(const f32x4*)(gp + bj * HALF + n * 16);
                        *(f32x4*)(op + bj * HALF + n * 16) = x + g * acc[ai][bj][m][n]; }
                asm volatile("" ::: "memory"); }
    }
};

template <class Epi> struct EpiTail {
    static constexpr bool PERM = Epi::PERM, AFTER_DRAIN = false;
    Epi E; float* slabs; unsigned* cnt; int s;
    __device__ __forceinline__ void operator()(const AccT& acc, const Unit& u, int wr, int wc, int fr, int fq) const {
        const int wave = wr * 4 + wc, tid = wave * 64 + fq * 16 + fr;
        const __amdgpu_buffer_rsrc_t rs = __builtin_amdgcn_make_buffer_rsrc((void*)(slabs + (size_t)u.q * s * 65536), 0, s * 262144, 0x00020000);
        const unsigned off0 = (unsigned)u.p * 262144u + (unsigned)tid * 16u;
#pragma unroll
        for (int ai = 0; ai < 2; ++ai)
#pragma unroll
            for (int bj = 0; bj < 2; ++bj)
#pragma unroll
                for (int m = 0; m < 4; ++m)
#pragma unroll
                    for (int n = 0; n < 2; ++n) { const int k = ((ai * 2 + bj) * 4 + m) * 2 + n;
                        __builtin_amdgcn_raw_buffer_store_b128(__builtin_bit_cast(u32x4, acc[ai][bj][m][n]), rs, off0 + (unsigned)k * 8192u, 0, 16); }
        asm volatile("s_waitcnt vmcnt(0)" ::: "memory");
        unsigned old = 0;
        if (fq == 0 && fr == 0) old = __hip_atomic_fetch_add(cnt + u.q * 8 + wave, 1u, __ATOMIC_RELAXED, __HIP_MEMORY_SCOPE_AGENT);
        old = (unsigned)__builtin_amdgcn_readfirstlane((int)old);
        if (old == (unsigned)(s - 1)) {
            __builtin_amdgcn_fence(__ATOMIC_ACQUIRE, "agent");
            asm volatile("s_waitcnt vmcnt(0)" ::: "memory");
            AccT sum;
#pragma unroll
            for (int ai = 0; ai < 2; ++ai) {
#pragma unroll
                for (int bj = 0; bj < 2; ++bj)
#pragma unroll
                    for (int m = 0; m < 4; ++m)
#pragma unroll
                        for (int n = 0; n < 2; ++n) sum[ai][bj][m][n] = (f32x4){0.f, 0.f, 0.f, 0.f};
#pragma unroll 1
                for (int pp = 0; pp < s; ++pp) {
                    const unsigned po = (unsigned)pp * 262144u + (unsigned)tid * 16u + (unsigned)ai * 16u * 8192u;
#pragma unroll
                    for (int bj = 0; bj < 2; ++bj)
#pragma unroll
                        for (int m = 0; m < 4; ++m)
#pragma unroll
                            for (int n = 0; n < 2; ++n) { const int k = (bj * 4 + m) * 2 + n;
                                sum[ai][bj][m][n] += __builtin_bit_cast(f32x4, __builtin_amdgcn_raw_buffer_load_b128(rs, po + (unsigned)k * 8192u, 0, 16)); }
                }
            }
            E(sum, u, wr, wc, fr, fq);
        }
    }
};
template <class Epi, class Sched, bool ALIGN_EPI = false, bool SP2 = false>
__device__ __forceinline__ void gemm_phase(PG8_LAS unsigned char* lds, const Gemm g, const Sched& S, const Epi& E, const int wid  ) {
    const int lane = lane_id_fresh(), tid = wid * 64 + lane, wr = wid >> 2, wc = wid & 3, fr = lane & 15, fq = lane >> 4;
    const int K = g.K, nt = K / BK;
    unsigned voffA[2], voffB[2];
#pragma unroll
    for (int i = 0; i < 2; ++i) { int R, C; stage_rc(tid * 16 + i * 8192, R, C); const int Rb = Epi::PERM ? ((R & ~31) + perm32(R & 31)) : R;
        voffA[i] = (unsigned)(R * g.lda + C) * 2u; voffB[i] = (unsigned)(Rb * g.ldb + C) * 2u; }
    const size_t kstep = (size_t)(BK * 2);
    const size_t hstepA = (size_t)HALF * g.lda * 2, hstepB = (size_t)HALF * g.ldb * 2;
    const size_t tstepA = 2 * hstepA, tstepB = 2 * hstepB;
    const unsigned ldsw = (unsigned)wid * 1024u;
    const int aoff = lds_byte(wr * 64 + fr, fq * 8), boff = lds_byte(wc * 32 + fr, fq * 8);
#define PG8_SA(b, h) (((b) * 2 + (h)) * HTB)
#define PG8_SB(b, h) ((4 + (b) * 2 + (h)) * HTB)
#define PG8_STAGE(bufoff, gbase, voff) do { _Pragma("unroll") for (int _i = 0; _i < 2; ++_i) \
        __builtin_amdgcn_global_load_lds((const unsigned*)((const char*)(gbase) + (voff)[_i]), (PG8_LAS unsigned*)(lds + (bufoff) + ldsw + _i * 8192), 16, 0, 0); } while (0)
#define PG8_LDA(dst, b, h) do { _Pragma("unroll") for (int m = 0; m < 4; ++m) _Pragma("unroll") for (int k = 0; k < 2; ++k) dst[m][k] = *(const PG8_LAS bf16x8*)(lds + PG8_SA(b, h) + aoff + m * 2048 + k * 1024); } while (0)
#define PG8_LDB(dst, b, h) do { _Pragma("unroll") for (int n = 0; n < 2; ++n) _Pragma("unroll") for (int k = 0; k < 2; ++k) dst[n][k] = *(const PG8_LAS bf16x8*)(lds + PG8_SB(b, h) + boff + n * 2048 + k * 1024); } while (0)
#define PG8_MMA(ai, bj, At, Bt) do { __builtin_amdgcn_s_setprio(1); _Pragma("unroll") for (int m = 0; m < 4; ++m) _Pragma("unroll") for (int n = 0; n < 2; ++n) _Pragma("unroll") for (int k = 0; k < 2; ++k) \
        acc[ai][bj][m][n] = __builtin_amdgcn_mfma_f32_16x16x32_bf16(Bt[n][k], At[m][k], acc[ai][bj][m][n], 0, 0, 0); __builtin_amdgcn_s_setprio(0); } while (0)
#define PG8_WAIT_V(n) asm volatile("s_waitcnt vmcnt(" #n ")" ::: "memory")
#define PG8_WAIT_L(n) asm volatile("s_waitcnt lgkmcnt(" #n ")" ::: "memory")
#define PG8_BAR __builtin_amdgcn_s_barrier()
#define PG8_SCHED __builtin_amdgcn_sched_barrier(0)
#define PG8_KLOOP(G1, G0) _Pragma("unroll 1") \
        for (int t = 0; t < nt; t += 2) { \
            const bool last = (t == nt - 2); \
            const char* a1 = cA + (size_t)(t + 1) * kstep; \
            const char* a2 = last ? nA : cA + (size_t)(t + 2) * kstep; const char* b2 = last ? nB : cB + (size_t)(t + 2) * kstep; \
            const char* a3 = a2 + kstep; const char* b3 = b2 + kstep; \
            if (last && has_next) S.a_ready(nxt); \
            if constexpr (SP2) { \
            PG8_LDB(B0, 0, 0); PG8_LDB(B1, 0, 1); PG8_SCHED; PG8_LDA(At, 0, 0); PG8_STAGE(PG8_SA(1, 1), a1 + hstepA, voffA); \
            PG8_WAIT_V(8); PG8_WAIT_L(0); PG8_BAR; if (G1) PG8_MMA(0, 0, At, B0); if (G0) PG8_MMA(0, 1, At, B1); PG8_BAR; PG8_SCHED; \
            PG8_LDA(At, 0, 1); PG8_STAGE(PG8_SB(0, 0), b2, voffB); PG8_STAGE(PG8_SB(0, 1), b2 + hstepB, voffB); PG8_STAGE(PG8_SA(0, 0), a2, voffA); \
            PG8_WAIT_V(8); PG8_WAIT_L(0); PG8_BAR; if (G1) PG8_MMA(1, 0, At, B0); if (G0) PG8_MMA(1, 1, At, B1); PG8_BAR; PG8_SCHED; \
            PG8_LDB(B0, 1, 0); PG8_LDB(B1, 1, 1); PG8_SCHED; PG8_LDA(At, 1, 0); PG8_STAGE(PG8_SA(0, 1), a2 + hstepA, voffA); \
            PG8_WAIT_V(8); PG8_WAIT_L(0); PG8_BAR; if (G1) PG8_MMA(0, 0, At, B0); if (G0) PG8_MMA(0, 1, At, B1); PG8_BAR; PG8_SCHED; \
            PG8_LDA(At, 1, 1); PG8_STAGE(PG8_SB(1, 0), b3, voffB); PG8_STAGE(PG8_SB(1, 1), b3 + hstepB, voffB); PG8_STAGE(PG8_SA(1, 0), a3, voffA); \
            PG8_WAIT_V(8); PG8_WAIT_L(0); PG8_BAR; if (G1) PG8_MMA(1, 0, At, B0); if (G0) PG8_MMA(1, 1, At, B1); PG8_BAR; PG8_SCHED; \
            } else { \
            PG8_LDB(B0, 0, 0); PG8_SCHED; PG8_LDA(At, 0, 0); PG8_STAGE(PG8_SA(1, 1), a1 + hstepA, voffA); \
            PG8_WAIT_L(8); PG8_BAR; PG8_WAIT_L(0); PG8_MMA(0, 0, At, B0); PG8_BAR; PG8_SCHED; \
            PG8_LDB(B1, 0, 1); PG8_STAGE(PG8_SB(0, 0), b2, voffB); \
            PG8_BAR; PG8_WAIT_L(0); PG8_MMA(0, 1, At, B1); PG8_BAR; \
            PG8_LDA(At, 0, 1); PG8_STAGE(PG8_SA(0, 0), a2, voffA); \
            PG8_BAR; PG8_WAIT_L(0); PG8_MMA(1, 0, At, B0); PG8_BAR; PG8_SCHED; \
            PG8_STAGE(PG8_SB(0, 1), b2 + hstepB, voffB); \
            PG8_WAIT_V(6); PG8_BAR; PG8_MMA(1, 1, At, B1); PG8_BAR; \
            PG8_LDB(B0, 1, 0); PG8_SCHED; PG8_LDA(At, 1, 0); PG8_STAGE(PG8_SA(0, 1), a2 + hstepA, voffA); \
            PG8_WAIT_L(8); PG8_BAR; PG8_WAIT_L(0); PG8_MMA(0, 0, At, B0); PG8_BAR; PG8_SCHED; \
            PG8_LDB(B1, 1, 1); PG8_STAGE(PG8_SB(1, 0), b3, voffB); \
            PG8_BAR; PG8_WAIT_L(0); PG8_MMA(0, 1, At, B1); PG8_BAR; \
            PG8_LDA(At, 1, 1); PG8_STAGE(PG8_SA(1, 0), a3, voffA); \
            PG8_BAR; PG8_WAIT_L(0); PG8_MMA(1, 0, At, B0); PG8_BAR; PG8_SCHED; \
            PG8_STAGE(PG8_SB(1, 1), b3 + hstepB, voffB); \
            PG8_WAIT_V(6); PG8_BAR; PG8_MMA(1, 1, At, B1); PG8_BAR; \
            } \
        }
    Unit cur, nxt; int ui = 0;
    if (!S.next(0, cur)) return;
    f32x4 acc[2][2][4][2];
#pragma unroll
    for (int a = 0; a < 2; ++a)
#pragma unroll
        for (int b = 0; b < 2; ++b)
#pragma unroll
            for (int m = 0; m < 4; ++m)
#pragma unroll
                for (int n = 0; n < 2; ++n) acc[a][b][m][n] = (f32x4){0.f, 0.f, 0.f, 0.f};
    bf16x8 At[4][2], B0[2][2], B1[2][2];
    const char* cA = (const char*)g.A + (size_t)cur.pm * tstepA + (size_t)cur.kofs * 2; const char* cB = (const char*)g.Bt + (size_t)cur.pn * tstepB + (size_t)cur.kofs * 2;
    S.a_ready(cur);
    if constexpr (SP2) {
        PG8_STAGE(PG8_SB(0, 0), cB, voffB); PG8_STAGE(PG8_SB(0, 1), cB + hstepB, voffB); PG8_STAGE(PG8_SA(0, 0), cA, voffA); PG8_STAGE(PG8_SA(0, 1), cA + hstepA, voffA);
        if (wr == 1) PG8_BAR;
        PG8_WAIT_V(2); PG8_BAR;
        PG8_STAGE(PG8_SB(1, 0), cB + kstep, voffB); PG8_STAGE(PG8_SA(1, 0), cA + kstep, voffA); PG8_STAGE(PG8_SB(1, 1), cB + hstepB + kstep, voffB);
        PG8_WAIT_V(6); PG8_BAR;
    } else {
        PG8_STAGE(PG8_SB(0, 0), cB, voffB); PG8_STAGE(PG8_SA(0, 0), cA, voffA); PG8_STAGE(PG8_SB(0, 1), cB + hstepB, voffB); PG8_STAGE(PG8_SA(0, 1), cA + hstepA, voffA);
        if (wr == 1) PG8_BAR;
        PG8_WAIT_V(4); PG8_BAR;
        PG8_STAGE(PG8_SB(1, 0), cB + kstep, voffB); PG8_STAGE(PG8_SA(1, 0), cA + kstep, voffA); PG8_STAGE(PG8_SB(1, 1), cB + hstepB + kstep, voffB);
        PG8_WAIT_V(6); PG8_BAR;
    }
    for (;;) {
        const bool has_next = S.next(ui + 1, nxt);
        const char* nA = has_next ? (const char*)g.A + (size_t)nxt.pm * tstepA + (size_t)nxt.kofs * 2 : cA; const char* nB = has_next ? (const char*)g.Bt + (size_t)nxt.pn * tstepB + (size_t)nxt.kofs * 2 : cB;
        if (cur.nh < 0) { PG8_KLOOP(true, true) } else { PG8_KLOOP(cur.nh != 1, cur.nh != 0) }
        if constexpr (ALIGN_EPI) { if (wr == 0) PG8_BAR; }
        if constexpr (!Epi::AFTER_DRAIN) { E(acc, cur, wr, wc, fr, fq); S.done(cur); }
        if (!has_next) break;
#pragma unroll
        for (int a = 0; a < 2; ++a)
#pragma unroll
            for (int b = 0; b < 2; ++b)
#pragma unroll
                for (int m = 0; m < 4; ++m)
#pragma unroll
                    for (int n = 0; n < 2; ++n) acc[a][b][m][n] = (f32x4){0.f, 0.f, 0.f, 0.f};
        cur = nxt; cA = nA; cB = nB; ++ui;
        if constexpr (ALIGN_EPI) { if (wr == 1) PG8_BAR; }
    }
    PG8_WAIT_V(0);
    if constexpr (!ALIGN_EPI) { if (wr == 0) PG8_BAR; }
    PG8_BAR;
    if constexpr (Epi::AFTER_DRAIN) { E.fused(acc, cur, wr, wc, fr, fq, lds, wid, lane); S.done(cur); }
#undef PG8_KLOOP
#undef PG8_SA
#undef PG8_SB
#undef PG8_STAGE
#undef PG8_LDA
#undef PG8_LDB
#undef PG8_MMA
#undef PG8_WAIT_V
#undef PG8_WAIT_L
#undef PG8_BAR
#undef PG8_SCHED
}
}
#define XB_TMO      128
#define XB_XCNT(j)  (256  + 64 * (j))
#define XB_XSUB(j)  (1280 + 64 * (j))
#define XB_XGEN(j)  (2304 + 64 * (j))
#define XB_TOP      3328
#define XB_TOPGEN   3392
#define XCD_BAR_WORDS 3456
#define XB_SPIN_CAP (1u << 18)

__device__ __forceinline__ unsigned xb_ld(unsigned* p)              { return __hip_atomic_load(p, __ATOMIC_RELAXED, __HIP_MEMORY_SCOPE_AGENT); }
__device__ __forceinline__ unsigned xb_add(unsigned* p, unsigned v) { return __hip_atomic_fetch_add(p, v, __ATOMIC_RELAXED, __HIP_MEMORY_SCOPE_AGENT); }
__device__ __forceinline__ unsigned xb_xcc_id() { return (unsigned)__builtin_amdgcn_s_getreg((3 << 11) | 20) & 0xFu; }
#define XB_SPIN(cond, bar) do { unsigned _sp = 0; while (cond) { __builtin_amdgcn_s_sleep(1); \
    if ((++_sp & 255u) == 0u) { if (xb_ld(&(bar)[XB_TMO])) break; if (_sp > XB_SPIN_CAP) { atomicAdd(&(bar)[XB_TMO], 1u); break; } } } } while (0)

struct XcdBarrier {
    unsigned* bar; unsigned x;
    volatile LAS unsigned* st;
};

__device__ __forceinline__ XcdBarrier xcd_barrier_post(unsigned* bar, volatile LAS unsigned* st) {
    XcdBarrier b; b.bar = bar; b.x = xb_xcc_id(); b.st = st;
    if (threadIdx.x == 0) (void)xb_add(&bar[XB_XCNT(b.x)], 1u);
    return b;
}
__device__ __forceinline__ void xcd_barrier_complete(unsigned* bar, unsigned x, unsigned& nloc, unsigned& nx) {
    const unsigned G = gridDim.x * gridDim.y * gridDim.z;
    unsigned sum, cnt, mine, sp = 0u;
    for (;;) {
        sum = 0u; cnt = 0u; mine = 0u;
#pragma unroll
        for (unsigned j = 0; j < 16; ++j) { const unsigned c = xb_ld(&bar[XB_XCNT(j)]); sum += c; cnt += (c > 0u) ? 1u : 0u; mine = (j == x) ? c : mine; }
        if (sum == G) break;
        __builtin_amdgcn_s_sleep(1);
        if ((++sp & 255u) == 0u) { if (xb_ld(&bar[XB_TMO])) break; if (sp > XB_SPIN_CAP) { atomicAdd(&bar[XB_TMO], 1u); break; } }
    }
    nloc = mine > 0u ? mine : 1u; nx = cnt > 0u ? cnt : 1u;
}

__device__ __forceinline__ void xcd_barrier(const XcdBarrier& b) {
    asm volatile("s_waitcnt vmcnt(0)" ::: "memory");
    __syncthreads();
    if (threadIdx.x == 0) {
        unsigned* bar = b.bar;
        __builtin_amdgcn_s_waitcnt(0);
        unsigned nloc = b.st[0], nx = b.st[1];
        if (nloc == 0u) { xcd_barrier_complete(bar, b.x, nloc, nx); b.st[0] = nloc; b.st[1] = nx; }
        const unsigned old = xb_add(&bar[XB_XSUB(b.x)], 1u);
        const unsigned gen = old / nloc;
        if (old + 1u == (gen + 1u) * nloc) {
            __builtin_amdgcn_fence(__ATOMIC_RELEASE, "agent");
            asm volatile("s_waitcnt vmcnt(0)" ::: "memory");
            const unsigned og = xb_add(&bar[XB_TOP], 1u);
            const unsigned tg = og / nx;
            if (og + 1u == (tg + 1u) * nx) xb_add(&bar[XB_TOPGEN], 1u);
            else XB_SPIN(xb_ld(&bar[XB_TOPGEN]) == tg, bar);
            __builtin_amdgcn_fence(__ATOMIC_ACQUIRE, "agent");
            xb_add(&bar[XB_XGEN(b.x)], 1u);
            asm volatile("s_waitcnt vmcnt(0)" ::: "memory");
        } else {
            XB_SPIN(xb_ld(&bar[XB_XGEN(b.x)]) == gen, bar);
            __builtin_amdgcn_fence(__ATOMIC_ACQUIRE, "agent");
            asm volatile("s_waitcnt vmcnt(0)" ::: "memory");
        }
    }
    __syncthreads();
}

typedef const float* InPtr;
typedef const __attribute__((address_space(4))) InPtr* KTab;
struct Ctx {
    KTab in; float* out; unsigned char* ws;
    LAS unsigned char* lds; int tid, lane, wave, G, bid;
    template <class T> __device__ __forceinline__ T* W(size_t off) const { return (T*)(ws + off); }
};
enum { I_XP = 0, I_XS, I_CP, I_CS, I_CK, I_CV, I_CKI, I_PT, I_SRW, I_SSH, I_SCV, I_WADA, I_BADA, I_N1G, I_N2G, I_WIN, I_MU, I_W0, I_WDEC, I_A0, I_WAUP, I_WGUP,
       I_KK, I_KA, I_RK, I_LNW, I_LNB, I_QNG, I_KNG, I_WPA, I_WPB, I_WOUT, I_WUP, I_CW, I_CB, I_WDN };

__device__ __forceinline__ void tconv(const Ctx& X, const float* __restrict__ src, int K, int N, bf16_t* __restrict__ dst, int ldd, int Kpad, int Npad) {
    const int nkt = Kpad / 128, nnt = Npad / 128, ntile = nkt * nnt;
    LAS unsigned short* tile = (LAS unsigned short*)X.lds;
    const int tid = X.tid, kr = tid >> 5, nq = tid & 31;
    f32x4 v[8];
    auto ld = [&](int ti) { const int kt = ti % nkt, nt = ti / nkt; const int k = kt * 128 + kr, n = nt * 128 + 4 * nq;
#pragma unroll
        for (int j = 0; j < 8; ++j) { v[j] = (f32x4){0.f, 0.f, 0.f, 0.f}; if (n < N && k + 16 * j < K) v[j] = *(const f32x4*)(src + (size_t)(k + 16 * j) * N + n); } };
    if (X.bid < ntile) ld(X.bid);
    for (int ti = X.bid; ti < ntile; ti += X.G) {
        const int kt = ti % nkt, nt = ti / nkt;
#pragma unroll
        for (int j = 0; j < 8; ++j) { u32x2 w; w.x = cvt_pk_bf16(v[j][0], v[j][1]); w.y = cvt_pk_bf16(v[j][2], v[j][3]); *(LAS u32x2*)(tile + (kr + 16 * j) * 132 + 4 * nq) = w; }
        __syncthreads();
        if (ti + X.G < ntile) ld(ti + X.G);
        {
            const int n = tid & 127, kg = tid >> 7;
            bf16_t* d = dst + (size_t)(nt * 128 + n) * ldd + kt * 128 + 32 * kg;
#pragma unroll
            for (int h = 0; h < 4; ++h) { unsigned short e[8];
#pragma unroll
                for (int j = 0; j < 8; ++j) e[j] = tile[(32 * kg + 8 * h + j) * 132 + n];
                u32x4 w; w.x = e[0] | ((unsigned)e[1] << 16); w.y = e[2] | ((unsigned)e[3] << 16); w.z = e[4] | ((unsigned)e[5] << 16); w.w = e[6] | ((unsigned)e[7] << 16);
                *(u32x4*)(d + 8 * h) = w; }
        }
        __syncthreads();
    }
}

__device__ __forceinline__ void ada_in_prologue(const Ctx& X) {
    constexpr int NC = 48, RT = 9, KP = 264;
    if (X.bid * NC >= MODLD) return;
    LAS bf16_t* sA = (LAS bf16_t*)X.lds;
    LAS bf16_t* sB = sA + 144 * KP;
    const int tid = X.tid, lane = X.lane, wave = X.wave, fr = lane & 15, fq = lane >> 4, n0 = X.bid * NC;
    const float* wada = X.in[I_WADA]; const float* cp = X.in[I_CP]; const float* cs = X.in[I_CS];
    f32x4 acc[4];
#pragma unroll
    for (int i = 0; i < 4; ++i) acc[i] = (f32x4){0.f, 0.f, 0.f, 0.f};
    f32x4 wv[6];
    auto ldw = [&](int kc) {
#pragma unroll
        for (int i = 0; i < 6; ++i) { const int e = tid + 512 * i, k = e / 12, n4 = (e - k * 12) * 4; wv[i] = *(const f32x4*)(wada + (size_t)(kc * 256 + k) * MODLD + n0 + n4); } };
    ldw(0);
    for (int kc = 0; kc < DM / 256; ++kc) {
#pragma unroll 6
        for (int e = tid; e < 144 * 64; e += 512) { const int r = e >> 6, k4 = (e & 63) * 4; f32x4 v = {0.f, 0.f, 0.f, 0.f};
            if (r <= DEC_B) v = *(const f32x4*)((r == 0 ? cp : cs + (size_t)(r - 1) * DM) + kc * 256 + k4);
            u32x2 w; w.x = cvt_pk_bf16(v[0] * sigmoidf_(v[0]), v[1] * sigmoidf_(v[1])); w.y = cvt_pk_bf16(v[2] * sigmoidf_(v[2]), v[3] * sigmoidf_(v[3]));
            *(LAS u32x2*)(sA + r * KP + k4) = w; }
#pragma unroll
        for (int i = 0; i < 6; ++i) { const int e = tid + 512 * i, k = e / 12, n4 = (e - k * 12) * 4;
#pragma unroll
            for (int j = 0; j < 4; ++j) sB[(n4 + j) * KP + k] = f2bf(wv[i][j]); }
        __syncthreads();
        if (kc + 1 < DM / 256) ldw(kc + 1);
#pragma unroll
        for (int i = 0; i < 4; ++i) { const int pr = wave + 8 * i;
            if (pr < RT * 3) { const int rt = pr / 3, ct = pr - rt * 3;
#pragma unroll
                for (int ks = 0; ks < 8; ++ks) { const bf16x8 a = *(const LAS bf16x8*)(sA + (rt * 16 + fr) * KP + ks * 32 + fq * 8), b = *(const LAS bf16x8*)(sB + (ct * 16 + fr) * KP + ks * 32 + fq * 8);
                    acc[i] = __builtin_amdgcn_mfma_f32_16x16x32_bf16(a, b, acc[i], 0, 0, 0); } } }
        __syncthreads();
    }
    float* MOD = X.W<float>(WS_MOD);
#pragma unroll
    for (int i = 0; i < 4; ++i) { const int pr = wave + 8 * i;
        if (pr < RT * 3) { const int rt = pr / 3, ct = pr - rt * 3, n = n0 + ct * 16 + fr; const float bias = X.in[I_BADA][n];
#pragma unroll
            for (int j = 0; j < 4; ++j) { const int r = rt * 16 + 4 * fq + j; if (r <= DEC_B) MOD[(size_t)r * MODLD + n] = acc[i][j] + bias; } } }
}

__device__ __forceinline__ void phase_convert(const Ctx& X) {
    tconv(X, X.in[I_WIN], DM, IN_COLS, X.W<bf16_t>(WS_WIN), DM, DM, ZLD);
    tconv(X, X.in[I_WDEC], 96, DM, X.W<bf16_t>(WS_WDEC), 256, 256, DM);
    tconv(X, X.in[I_WAUP], 96, DM, X.W<bf16_t>(WS_WA), 256, 256, DM);
    tconv(X, X.in[I_WGUP], 256, DM, X.W<bf16_t>(WS_WG), 256, 256, DM);
    ada_in_prologue(X);
}

__device__ __forceinline__ void phase_norm_mod(const Ctx& X, const float* xp, const float* xs, const float* gn, int sh_off, int sc_off, bf16_t* dst) {
    const float* MOD = X.W<float>(WS_MOD);
    const int lane = X.lane;
    auto ld = [&](int t, f32x4 (&v)[8]) { const float* x = t < SEQ ? xp + (size_t)t * DM : xs + (size_t)(t - SEQ) * DM;
#pragma unroll
        for (int i = 0; i < 8; ++i) v[i] = ((const f32x4*)x)[lane + 64 * i]; };
    f32x4 v[8], v1[8];
    const int t0 = X.bid * 8 + X.wave, ts = X.G * 8;
    if (t0 < NTOK) ld(t0, v);
    if (t0 + ts < NTOK) ld(t0 + ts, v1); else {
#pragma unroll
        for (int i = 0; i < 8; ++i) v1[i] = v[i]; }
    for (int t = t0; t < NTOK; t += ts) {
        const float* mr = MOD + (size_t)(t < SEQ ? 0 : 1 + ((t - SEQ) >> 3)) * MODLD;
        f32x4 v2[8];
#pragma unroll
        for (int i = 0; i < 8; ++i) v2[i] = v1[i];
        if (t + 2 * ts < NTOK) ld(t + 2 * ts, v2);
        float ss = 0.f;
#pragma unroll
        for (int i = 0; i < 8; ++i) ss += v[i][0] * v[i][0] + v[i][1] * v[i][1] + v[i][2] * v[i][2] + v[i][3] * v[i][3];
        ss = wave_sum(ss);
        const float rs = rsqrtf(ss * (1.f / DM) + 1e-6f);
#pragma unroll
        for (int i = 0; i < 8; ++i) { const int c = 4 * (lane + 64 * i);
            const f32x4 g = *(const f32x4*)(gn + c), sc = *(const f32x4*)(mr + sc_off + c), sh = *(const f32x4*)(mr + sh_off + c);
            f32x4 y;
#pragma unroll
            for (int e = 0; e < 4; ++e) y[e] = v[i][e] * rs * g[e] * (1.f + sc[e]) + sh[e];
            u32x2 w; w.x = cvt_pk_bf16(y[0], y[1]); w.y = cvt_pk_bf16(y[2], y[3]);
            *(u32x2*)(dst + (size_t)t * DM + c) = w; }
#pragma unroll
        for (int i = 0; i < 8; ++i) { v[i] = v1[i]; v1[i] = v2[i]; }
    }
}

__device__ __forceinline__ void phase_prep1(const Ctx& X) {
    const bf16_t* Z = X.W<bf16_t>(WS_Z);
    const float* mu = X.in[I_MU];
    bf16_t* ADEC = X.W<bf16_t>(WS_ADEC); bf16_t* AAIN = X.W<bf16_t>(WS_AAIN); bf16_t* AGIN = X.W<bf16_t>(WS_AGIN);
    bf16_t* QB = X.W<bf16_t>(WS_QB); bf16_t* KB = X.W<bf16_t>(WS_KB); bf16_t* VB = X.W<bf16_t>(WS_VB); bf16_t* KIB = X.W<bf16_t>(WS_KIB); float* WI = X.W<float>(WS_WI);
    const int lane = X.lane;
    struct Raw { float zc[7], zp[7]; u32x4 q[4], k, v; };
    auto load = [&](int t, Raw& R) {
        const bf16_t* zr = Z + (size_t)t * ZLD;
        const bool smp = t >= SEQ; const int tt = smp ? t - SEQ : t; const int p = smp ? (tt & 7) : t; const int b = tt >> 3;
#pragma unroll
        for (int i = 0; i < 7; ++i) { const int c = C_WD + lane + 64 * i;
            R.zc[i] = bf2f(zr[c]);
            float zp = 0.f; if (p > 0) zp = bf2f(zr[c - ZLD]); else if (smp) zp = X.in[I_SSH][(size_t)b * SHIFT_W + c];
            R.zp[i] = zp; }
#pragma unroll
        for (int i = 0; i < 4; ++i) R.q[i] = *(const u32x4*)(zr + C_Q + 8 * (lane + 64 * i));
        R.k = *(const u32x4*)(zr + C_KK + 8 * lane); R.v = *(const u32x4*)(zr + C_VV + 8 * lane); };
    Raw R, R1;
    const int t0 = X.bid * 8 + X.wave;
    if (t0 < NTOK) load(t0, R);
    R1 = R; if (t0 + X.G * 8 < NTOK) load(t0 + X.G * 8, R1);
    for (int t = t0; t < NTOK; t += X.G * 8) {
        Raw Rn = R1;
        if (t + 2 * X.G * 8 < NTOK) load(t + 2 * X.G * 8, Rn);
        const bf16_t* zr = Z + (size_t)t * ZLD;
        const u32x4 kiw = *(const u32x4*)(zr + C_KI + 8 * (lane & 7)); const float wiw = bf2f(zr[C_WI + (lane & 15)]);
        const bool smp = t >= SEQ; const int tt = smp ? t - SEQ : t; const int p = smp ? (tt & 7) : t; const int b = tt >> 3;
#pragma unroll
        for (int i = 0; i < 7; ++i) { const int c = C_WD + lane + 64 * i;
            const float zc = R.zc[i], zp = R.zp[i];
            const float zs = zc + (zp - zc) * mu[c];
            if (c < C_AD) ADEC[(size_t)t * 256 + (c - C_WD)] = f2bf(tanhf(zs));
            else if (c < C_GD) AAIN[(size_t)t * 256 + (c - C_AD)] = f2bf(zs);
            else AGIN[(size_t)t * 256 + (c - C_GD)] = f2bf(sigmoidf_(zs)); }
        for (int c = 96 + lane; c < 256; c += 64) { ADEC[(size_t)t * 256 + c] = 0; AAIN[(size_t)t * 256 + c] = 0; }
#pragma unroll
        for (int i = 0; i < 4; ++i) { const int e = 8 * (lane + 64 * i); float f[8]; unpack8(R.q[i], f);
            float ss = 0.f;
#pragma unroll
            for (int j = 0; j < 8; ++j) ss += f[j] * f[j];
            ss = row16_sum(ss); const float rs = rsqrtf(ss * (1.f / 128.f) + 1e-6f) * 0.08838834764831845f;
            const float* g = X.in[I_QNG] + (e & 127);
#pragma unroll
            for (int j = 0; j < 8; ++j) f[j] = f[j] * rs * g[j];
            *(u32x4*)(QB + (size_t)t * DM + e) = pack8(f);
            if (!smp) {
#pragma unroll
                for (int j = 0; j < 8; ++j) f[j] *= 11.313708498984761f;
                *(u32x2*)(X.W<unsigned char>(WS_Q8) + (size_t)t * DM + e) = pack8_fp8(f); } }
        { const int e = 8 * lane; float f[8]; unpack8(R.k, f);
            float ss = 0.f;
#pragma unroll
            for (int j = 0; j < 8; ++j) ss += f[j] * f[j];
            ss = row16_sum(ss); const float rs = rsqrtf(ss * (1.f / 128.f) + 1e-6f);
            const float* g = X.in[I_KNG] + (e & 127);
#pragma unroll
            for (int j = 0; j < 8; ++j) f[j] = f[j] * rs * g[j];
            *(u32x4*)(KB + (size_t)t * 512 + e) = pack8(f);
            if (!smp) { const int d0 = e & 127; *(u32x2*)(X.W<unsigned char>(WS_K8) + (size_t)(e >> 7) * (SEQ * 128) + (size_t)t * 128 + (d0 >> 6) * 64 + ((d0 >> 3) & 3) * 16 + ((d0 >> 5) & 1) * 8) = pack8_fp8(f); }
            float* ko = X.out + (smp ? O_KS : O_KP) + (size_t)tt * 512 + e;
            *(f32x4*)ko = (f32x4){f[0], f[1], f[2], f[3]}; *(f32x4*)(ko + 4) = (f32x4){f[4], f[5], f[6], f[7]};
            const u32x4 vw = R.v; unpack8(vw, f);
            *(u32x4*)(VB + (size_t)t * 512 + e) = vw;
            if (!smp) *(u32x2*)(X.W<unsigned char>(WS_V8) + (size_t)(e >> 7) * (SEQ * 128) + (size_t)t * 128 + (e & 127)) = pack8_fp8(f);
            float* vo = X.out + (smp ? O_VS : O_VP) + (size_t)tt * 512 + e;
            *(f32x4*)vo = (f32x4){f[0], f[1], f[2], f[3]}; *(f32x4*)(vo + 4) = (f32x4){f[4], f[5], f[6], f[7]}; }
        if (lane < 8) { const int e = 8 * lane; float f[8]; const u32x4 kw = kiw; unpack8(kw, f);
            *(u32x4*)((unsigned char*)KIB + (size_t)(t >> 5) * 4096 + (lane >> 1) * 1024 + ((t & 31) + 32 * (lane & 1)) * 16) = kw;
            float* ko = X.out + (smp ? O_KIS : O_KIP) + (size_t)tt * 64 + e;
            *(f32x4*)ko = (f32x4){f[0], f[1], f[2], f[3]}; *(f32x4*)(ko + 4) = (f32x4){f[4], f[5], f[6], f[7]}; }
        if (lane < 16) WI[(size_t)t * 16 + lane] = wiw * 0.03125f;
        if (t == SEQ - 1 || (smp && p == 7)) { float* so = X.out + (smp ? O_SHS + (size_t)b * SHIFT_W : O_SHP);
#pragma unroll
            for (int i = 0; i < 13; ++i) { const int c8 = lane + 64 * i;
                if (c8 < SHIFT_W / 8) { float f[8]; unpack8(*(const u32x4*)(zr + 8 * c8), f); *(f32x4*)(so + 8 * c8) = (f32x4){f[0], f[1], f[2], f[3]}; *(f32x4*)(so + 8 * c8 + 4) = (f32x4){f[4], f[5], f[6], f[7]}; } } }
        R = R1; R1 = Rn;
    }
}

__device__ __forceinline__ void phase_prep2(const Ctx& X) {
    const bf16_t* Z = X.W<bf16_t>(WS_Z); const bf16_t* AAO = X.W<bf16_t>(WS_AAO);
    const float* mu = X.in[I_MU];
    bf16_t* RS = X.W<bf16_t>(WS_RS); bf16_t* KS = X.W<bf16_t>(WS_KS); bf16_t* VS = X.W<bf16_t>(WS_VS); bf16_t* AS = X.W<bf16_t>(WS_AS); bf16_t* BS = X.W<bf16_t>(WS_BS);
    float* BON = X.W<float>(WS_BON);
    const int lane = X.lane;
    for (int t = SEQ + X.bid * 8 + X.wave; t < NTOK; t += X.G * 8) {
        const bf16_t* zr = Z + (size_t)t * ZLD;
        const bool smp = t >= SEQ; const int tt = smp ? t - SEQ : t; const int p = smp ? (tt & 7) : t; const int b = tt >> 3;
        const float* sprev = X.in[I_SSH] + (size_t)b * SHIFT_W;
#pragma unroll
        for (int i = 0; i < 4; ++i) { const int e = 8 * (lane + 64 * i);
            float r[8], k[8], v[8], a[8], pr[8], pk[8], pv[8];
            unpack8(*(const u32x4*)(zr + C_R + e), r); unpack8(*(const u32x4*)(zr + C_K + e), k); unpack8(*(const u32x4*)(zr + C_V + e), v);
            unpack8(*(const u32x4*)(AAO + (size_t)t * DM + e), a);
            if (p > 0) { unpack8(*(const u32x4*)(zr - ZLD + C_R + e), pr); unpack8(*(const u32x4*)(zr - ZLD + C_K + e), pk); unpack8(*(const u32x4*)(zr - ZLD + C_V + e), pv); }
            else if (smp) {
#pragma unroll
                for (int j = 0; j < 8; ++j) { pr[j] = sprev[C_R + e + j]; pk[j] = sprev[C_K + e + j]; pv[j] = sprev[C_V + e + j]; } }
            else {
#pragma unroll
                for (int j = 0; j < 8; ++j) { pr[j] = 0.f; pk[j] = 0.f; pv[j] = 0.f; } }
            float kk[8], kp[8], bs[8], ss = 0.f, bo = 0.f;
#pragma unroll
            for (int j = 0; j < 8; ++j) {
                r[j] = r[j] + (pr[j] - r[j]) * mu[C_R + e + j]; k[j] = k[j] + (pk[j] - k[j]) * mu[C_K + e + j]; v[j] = v[j] + (pv[j] - v[j]) * mu[C_V + e + j];
                kk[j] = k[j] * X.in[I_KK][e + j]; ss += kk[j] * kk[j];
                kp[j] = k[j] * (1.f + (a[j] - 1.f) * X.in[I_KA][e + j]);
                bo += r[j] * kp[j] * X.in[I_RK][e + j]; }
            ss = row8_sum(ss); bo = row8_sum(bo);
            const float inv = 1.f / fmaxf(sqrtf(ss), 1e-12f);
#pragma unroll
            for (int j = 0; j < 8; ++j) { kk[j] *= inv; bs[j] = kk[j] * a[j]; kk[j] = -kk[j]; }
            *(u32x4*)(RS + (size_t)t * DM + e) = pack8(r); *(u32x4*)(KS + (size_t)t * DM + e) = pack8(kp); *(u32x4*)(VS + (size_t)t * DM + e) = pack8(v);
            *(u32x4*)(AS + (size_t)t * DM + e) = pack8(kk); *(u32x4*)(BS + (size_t)t * DM + e) = pack8(bs);
            if ((lane & 7) == 0) BON[(size_t)t * 32 + (e >> 6)] = bo; }
    }
}

constexpr int SCAN_STEP = 512;
constexpr int SCAN_WLDS = 8 * SCAN_STEP * 4 + 6 * 64 * 4;
struct ScanRegs { u32x4 v[7]; float bon; };
__device__ __forceinline__ void scan_load(const Ctx& X, ScanRegs& R, int tok0, int h, int lane, bool need_r, bool need_v, bool need_g) {
    const size_t off = (size_t)(tok0 + (lane >> 3)) * DM + h * 64 + (lane & 7) * 8;
    R.v[0] = *(const u32x4*)(X.W<bf16_t>(WS_AS) + off); R.v[1] = *(const u32x4*)(X.W<bf16_t>(WS_LW) + off); R.v[2] = *(const u32x4*)(X.W<bf16_t>(WS_BS) + off);
    R.v[3] = *(const u32x4*)(X.W<bf16_t>(WS_KS) + off);
    if (need_r) R.v[4] = *(const u32x4*)(X.W<bf16_t>(WS_RS) + off);
    if (need_v) R.v[5] = *(const u32x4*)(X.W<bf16_t>(WS_VS) + off);
    if (need_g) { R.v[6] = *(const u32x4*)(X.W<bf16_t>(WS_GG) + off); R.bon = X.W<float>(WS_BON)[(size_t)(tok0 + (lane & 7)) * 32 + h]; }
}
__device__ __forceinline__ void scan_store(LAS float* wl, const ScanRegs& R, int lane, bool need_r, bool need_v, bool need_g) {
    LAS float* base = wl + (lane >> 3) * SCAN_STEP + (lane & 7) * 8;
    if (need_g && lane < 8) wl[lane * SCAN_STEP + 448] = R.bon;
#pragma unroll
    for (int vi = 0; vi < 7; ++vi) {
        if ((vi == 4 && !need_r) || (vi == 5 && !need_v) || (vi == 6 && !need_g)) continue;
        float f[8]; unpack8(R.v[vi], f);
        if (vi == 1) {
#pragma unroll
            for (int j = 0; j < 8; ++j) f[j] = __expf(f[j]); }
        *(LAS f32x4*)(base + vi * 64) = (f32x4){f[0], f[1], f[2], f[3]}; *(LAS f32x4*)(base + vi * 64 + 4) = (f32x4){f[4], f[5], f[6], f[7]};
    }
}
#define CBAR() asm volatile("" ::: "memory")
template <bool HAS_V, bool HAS_OUT>
__device__ __forceinline__ float scan_step(float (&S)[64], const LAS float* sv, int lane) {
    const LAS f32x4* A4 = (const LAS f32x4*)sv;
    float s0 = 0.f, s1 = 0.f, s2 = 0.f, s3 = 0.f;
#pragma unroll
    for (int q = 0; q < 16; ++q) { const f32x4 a = A4[q]; s0 = fmaf(S[4 * q], a[0], s0); s1 = fmaf(S[4 * q + 1], a[1], s1); s2 = fmaf(S[4 * q + 2], a[2], s2); s3 = fmaf(S[4 * q + 3], a[3], s3);
        if ((q & 7) == 7) CBAR(); }
    const float sa = (s0 + s1) + (s2 + s3);
    const float vi = HAS_V ? sv[320 + lane] : 0.f;
    float o0 = 0.f, o1 = 0.f, o2 = 0.f, o3 = 0.f;
#pragma unroll
    for (int q = 0; q < 16; ++q) { const f32x4 w = A4[16 + q], b = A4[32 + q];
        if (HAS_V) { const f32x4 k = A4[48 + q];
            S[4 * q] = fmaf(S[4 * q], w[0], fmaf(sa, b[0], vi * k[0])); S[4 * q + 1] = fmaf(S[4 * q + 1], w[1], fmaf(sa, b[1], vi * k[1]));
            S[4 * q + 2] = fmaf(S[4 * q + 2], w[2], fmaf(sa, b[2], vi * k[2])); S[4 * q + 3] = fmaf(S[4 * q + 3], w[3], fmaf(sa, b[3], vi * k[3]));
        } else {
            S[4 * q] = fmaf(S[4 * q], w[0], sa * b[0]); S[4 * q + 1] = fmaf(S[4 * q + 1], w[1], sa * b[1]);
            S[4 * q + 2] = fmaf(S[4 * q + 2], w[2], sa * b[2]); S[4 * q + 3] = fmaf(S[4 * q + 3], w[3], sa * b[3]); }
        if (HAS_OUT) { const f32x4 r = A4[64 + q]; o0 = fmaf(S[4 * q], r[0], o0); o1 = fmaf(S[4 * q + 1], r[1], o1); o2 = fmaf(S[4 * q + 2], r[2], o2); o3 = fmaf(S[4 * q + 3], r[3], o3); }
        if ((q & 3) == 3) CBAR();
    }
    return (o0 + o1) + (o2 + o3);
}

__device__ __forceinline__ void scan_step_dual(float (&Su)[64], float (&Sp)[64], const LAS float* sv, int lane, float& ur, float& qv) {
    const LAS f32x4* A4 = (const LAS f32x4*)sv;
    float u0 = 0.f, u1 = 0.f, u2 = 0.f, u3 = 0.f, p0 = 0.f, p1 = 0.f, p2 = 0.f, p3 = 0.f;
#pragma unroll
    for (int q = 0; q < 16; ++q) { const f32x4 a = A4[q];
        u0 = fmaf(Su[4 * q], a[0], u0); u1 = fmaf(Su[4 * q + 1], a[1], u1); u2 = fmaf(Su[4 * q + 2], a[2], u2); u3 = fmaf(Su[4 * q + 3], a[3], u3);
        p0 = fmaf(Sp[4 * q], a[0], p0); p1 = fmaf(Sp[4 * q + 1], a[1], p1); p2 = fmaf(Sp[4 * q + 2], a[2], p2); p3 = fmaf(Sp[4 * q + 3], a[3], p3);
        if ((q & 7) == 7) CBAR(); }
    const float sau = (u0 + u1) + (u2 + u3), sap = (p0 + p1) + (p2 + p3);
    const float vi = sv[320 + lane];
#pragma unroll
    for (int q = 0; q < 16; ++q) { const f32x4 w = A4[16 + q], b = A4[32 + q], k = A4[48 + q];
#pragma unroll
        for (int e = 0; e < 4; ++e) { Su[4 * q + e] = fmaf(Su[4 * q + e], w[e], fmaf(sau, b[e], vi * k[e])); Sp[4 * q + e] = fmaf(Sp[4 * q + e], w[e], sap * b[e]); }
        if ((q & 1) == 1) CBAR();
    }
    float x0 = 0.f, x1 = 0.f, x2 = 0.f, x3 = 0.f, y0 = 0.f, y1 = 0.f, y2 = 0.f, y3 = 0.f;
#pragma unroll
    for (int q = 0; q < 16; ++q) { const f32x4 r = A4[64 + q];
        x0 = fmaf(Su[4 * q], r[0], x0); x1 = fmaf(Su[4 * q + 1], r[1], x1); x2 = fmaf(Su[4 * q + 2], r[2], x2); x3 = fmaf(Su[4 * q + 3], r[3], x3);
        y0 = fmaf(Sp[4 * q], r[0], y0); y1 = fmaf(Sp[4 * q + 1], r[1], y1); y2 = fmaf(Sp[4 * q + 2], r[2], y2); y3 = fmaf(Sp[4 * q + 3], r[3], y3);
        if ((q & 7) == 7) CBAR(); }
    ur = (x0 + x1) + (x2 + x3); qv = (y0 + y1) + (y2 + y3);
}
struct ScanRaw { u32x4 zr, zk, zv, pr, pk, pv, aa, lw; };
__device__ __forceinline__ void scanA_load(const Ctx& X, ScanRaw& R, int tok0, int h, int lane) {
    const unsigned t = tok0 + (lane >> 3), c = h * 64 + (lane & 7) * 8;
    const unsigned char* zb = X.ws + WS_Z;
    const unsigned zo = (t * ZLD + c) * 2u, ao = (t * DM + c) * 2u;
    R.zr = *(const u32x4*)(zb + (zo + C_R * 2u)); R.zk = *(const u32x4*)(zb + (zo + C_K * 2u)); R.zv = *(const u32x4*)(zb + (zo + C_V * 2u));
    if (t > 0) { const unsigned po = zo - ZLD * 2u; R.pr = *(const u32x4*)(zb + (po + C_R * 2u)); R.pk = *(const u32x4*)(zb + (po + C_K * 2u)); R.pv = *(const u32x4*)(zb + (po + C_V * 2u)); }
    else { R.pr = (u32x4){0u, 0u, 0u, 0u}; R.pk = R.pr; R.pv = R.pr; }
    R.aa = *(const u32x4*)(X.ws + WS_AAO + ao); R.lw = *(const u32x4*)(X.ws + WS_LW + ao);
}
__device__ __forceinline__ void scanA_store(const Ctx& X, LAS float* wl, const LAS float* cst, const ScanRaw& R, int tok0, int h, int lane) {
    const int part = lane & 7, t = tok0 + (lane >> 3);
    LAS float* base = wl + (lane >> 3) * SCAN_STEP + part * 8;
    const LAS float* cp = cst + part * 8;
    float x[8], px[8], r[8], k[8], a[8];
    auto lerp_to = [&](const u32x4 cur, const u32x4 prev, int ci, float (&o)[8]) { unpack8(cur, x); unpack8(prev, px);
        const f32x4 m0 = *(const LAS f32x4*)(cp + ci * 64), m1 = *(const LAS f32x4*)(cp + ci * 64 + 4);
#pragma unroll
        for (int j = 0; j < 4; ++j) { o[j] = x[j] + (px[j] - x[j]) * m0[j]; o[4 + j] = x[4 + j] + (px[4 + j] - x[4 + j]) * m1[j]; } };
    { float v[8]; lerp_to(R.zv, R.pv, 2, v);
      *(LAS f32x4*)(base + 5 * 64) = (f32x4){v[0], v[1], v[2], v[3]}; *(LAS f32x4*)(base + 5 * 64 + 4) = (f32x4){v[4], v[5], v[6], v[7]};
      *(u32x4*)(X.ws + WS_VS + ((unsigned)(t * DM + h * 64 + part * 8) * 2u)) = pack8(v); }
    CBAR();
    { unpack8(R.lw, x);
#pragma unroll
      for (int j = 0; j < 8; ++j) x[j] = __expf(x[j]);
      *(LAS f32x4*)(base + 1 * 64) = (f32x4){x[0], x[1], x[2], x[3]}; *(LAS f32x4*)(base + 1 * 64 + 4) = (f32x4){x[4], x[5], x[6], x[7]}; }
    CBAR();
    lerp_to(R.zr, R.pr, 0, r);
    *(LAS f32x4*)(base + 4 * 64) = (f32x4){r[0], r[1], r[2], r[3]}; *(LAS f32x4*)(base + 4 * 64 + 4) = (f32x4){r[4], r[5], r[6], r[7]};
    CBAR();
    lerp_to(R.zk, R.pk, 1, k);
    unpack8(R.aa, a);
    float kk[8], ss = 0.f, bo = 0.f;
    { const f32x4 c0 = *(const LAS f32x4*)(cp + 3 * 64), c1 = *(const LAS f32x4*)(cp + 3 * 64 + 4), d0 = *(const LAS f32x4*)(cp + 4 * 64), d1 = *(const LAS f32x4*)(cp + 4 * 64 + 4);
#pragma unroll
      for (int j = 0; j < 8; ++j) { const float kkc = j < 4 ? c0[j & 3] : c1[j & 3], kac = j < 4 ? d0[j & 3] : d1[j & 3];
          kk[j] = k[j] * kkc; ss += kk[j] * kk[j];
          k[j] = k[j] * (1.f + (a[j] - 1.f) * kac); } }
    *(LAS f32x4*)(base + 3 * 64) = (f32x4){k[0], k[1], k[2], k[3]}; *(LAS f32x4*)(base + 3 * 64 + 4) = (f32x4){k[4], k[5], k[6], k[7]};
    { const f32x4 e0 = *(const LAS f32x4*)(cp + 5 * 64), e1 = *(const LAS f32x4*)(cp + 5 * 64 + 4), r0 = *(const LAS f32x4*)(base + 4 * 64), r1 = *(const LAS f32x4*)(base + 4 * 64 + 4);
#pragma unroll
      for (int j = 0; j < 4; ++j) bo += r0[j] * k[j] * e0[j] + r1[j] * k[4 + j] * e1[j]; }
    CBAR();
    ss = row8_sum(ss); bo = row8_sum(bo);
    const float inv = 1.f / fmaxf(sqrtf(ss), 1e-12f);
#pragma unroll
    for (int j = 0; j < 8; ++j) { kk[j] *= inv; a[j] *= kk[j]; kk[j] = -kk[j]; }
    *(LAS f32x4*)(base + 0 * 64) = (f32x4){kk[0], kk[1], kk[2], kk[3]}; *(LAS f32x4*)(base + 0 * 64 + 4) = (f32x4){kk[4], kk[5], kk[6], kk[7]};
    *(LAS f32x4*)(base + 2 * 64) = (f32x4){a[0], a[1], a[2], a[3]}; *(LAS f32x4*)(base + 2 * 64 + 4) = (f32x4){a[4], a[5], a[6], a[7]};
    if (part == 0) *(float*)(X.ws + WS_BON + ((unsigned)(t * 32 + h) * 4u)) = bo;
}
__device__ __forceinline__ void phase_scan_a(const Ctx& X) {
    LAS float* wl = (LAS float*)(X.lds + X.wave * SCAN_WLDS);
    LAS float* cst = wl + 8 * SCAN_STEP;
    float* PC = X.W<float>(WS_PC); float* UC = X.W<float>(WS_UC);
    const int lane = X.lane;
    for (int task = X.bid * 8 + X.wave; task < NCHUNK * 32; task += X.G * 8) {
        const int c = task >> 5, h = task & 31, tok0 = c * CHUNK;
        float Su[64], Sp[64];
        int ln = lane; asm volatile("" : "+v"(ln));
#pragma unroll
        for (int j = 0; j < 64; ++j) { Su[j] = 0.f; Sp[j] = (j == ln) ? 1.f : 0.f; }
        { const int ch = h * 64 + lane; const float* mu = X.in[I_MU];
          cst[lane] = mu[C_R + ch]; cst[64 + lane] = mu[C_K + ch]; cst[128 + lane] = mu[C_V + ch];
          cst[192 + lane] = X.in[I_KK][ch]; cst[256 + lane] = X.in[I_KA][ch]; cst[320 + lane] = X.in[I_RK][ch]; }
        ScanRaw R; scanA_load(X, R, tok0, h, ln);
        unsigned char* QU = X.ws + WS_QV;
        wave_sync();
        for (int sb = 0; sb < CHUNK / 8; ++sb) {
            int l2 = lane; asm volatile("" : "+v"(l2));
            scanA_store(X, wl, cst, R, tok0 + 8 * sb, h, l2);
            wave_sync();
            if (sb + 1 < CHUNK / 8) scanA_load(X, R, tok0 + 8 * (sb + 1), h, l2);
            unsigned qo = (unsigned)((tok0 + 8 * sb) * DM + h * 64 + l2) * 4u;
#pragma unroll 1
            for (int s = 0; s < 8; ++s) { float ur, qv; scan_step_dual(Su, Sp, wl + s * SCAN_STEP, lane, ur, qv);
                *(unsigned*)(QU + qo) = cvt_pk_bf16(qv, ur); qo += DM * 4u; }
            wave_sync();
        }
        float* du = UC + (size_t)(c * 32 + h) * 4096 + ln; float* dp = PC + (size_t)(c * 32 + h) * 4096 + ln;
#pragma unroll
        for (int j = 0; j < 64; ++j) du[j * 64] = Su[j];
#pragma unroll
        for (int j = 0; j < 64; ++j) dp[j * 64] = Sp[j];
    }
}

__device__ __forceinline__ void phase_scan_b(const Ctx& X) {
    if (X.bid >= 32) return;
    const int h = X.bid, lane = X.lane, w = X.wave, n16 = lane & 15, kq = lane >> 4;
    LAS float* sS = (LAS float*)X.lds;
    const float* PC = X.W<float>(WS_PC); const float* UC = X.W<float>(WS_UC); float* SC = X.W<float>(WS_SC);
    for (int i = X.tid; i < 2 * 64 * 68; i += 512) sS[i] = 0.f;
    constexpr int PD = 6;
    float pb[PD][16]; f32x4 ub[PD][2];
    const int cb = w & 3, r0 = w >> 2;
    auto ldp = [&](int c, float (&p)[16], f32x4 (&u)[2]) { const float* pc = PC + (size_t)(c * 32 + h) * 4096 + (16 * cb + n16) * 64 + 16 * kq;
#pragma unroll
        for (int q4 = 0; q4 < 4; ++q4) { const f32x4 v = *(const f32x4*)(pc + 4 * q4); p[4 * q4] = v[0]; p[4 * q4 + 1] = v[1]; p[4 * q4 + 2] = v[2]; p[4 * q4 + 3] = v[3]; }
#pragma unroll
        for (int g = 0; g < 2; ++g) u[g] = *(const f32x4*)(UC + (size_t)(c * 32 + h) * 4096 + (16 * cb + n16) * 64 + 16 * (r0 + 2 * g) + 4 * kq); };
#pragma unroll
    for (int d = 0; d < PD; ++d) ldp(d, pb[d], ub[d]);
    __syncthreads();
    auto step = [&](int c, float (&p)[16], f32x4 (&u)[2]) {
        const LAS float* cur = sS + (c & 1) * 4352; LAS float* nxt = sS + ((c + 1) & 1) * 4352;
        const LAS float* a0 = cur + (16 * r0 + n16) * 68 + 16 * kq; const LAS float* a1 = a0 + 32 * 68;
        f32x4 x0 = u[0], x1 = {0.f, 0.f, 0.f, 0.f}, y0 = u[1], y1 = {0.f, 0.f, 0.f, 0.f};
#pragma unroll
        for (int kk = 0; kk < 16; kk += 2) {
            x0 = __builtin_amdgcn_mfma_f32_16x16x4f32(a0[kk], p[kk], x0, 0, 0, 0);
            y0 = __builtin_amdgcn_mfma_f32_16x16x4f32(a1[kk], p[kk], y0, 0, 0, 0);
            x1 = __builtin_amdgcn_mfma_f32_16x16x4f32(a0[kk + 1], p[kk + 1], x1, 0, 0, 0);
            y1 = __builtin_amdgcn_mfma_f32_16x16x4f32(a1[kk + 1], p[kk + 1], y1, 0, 0, 0); }
        const f32x4 sx = x0 + x1, sy = y0 + y1;
        ldp(c + PD < NCHUNK ? c + PD : NCHUNK - 1, p, u);
        float* dst = SC + (size_t)(((c + 1) & (NCHUNK - 1)) * 32 + h) * 4096 + (16 * cb + n16) * 64 + 16 * r0 + 4 * kq;
        *(f32x4*)dst = sx; *(f32x4*)(dst + 32) = sy;
#pragma unroll
        for (int j = 0; j < 4; ++j) { const int rx = 16 * r0 + 4 * kq + j, col = 16 * cb + n16;
            nxt[rx * 68 + col] = sx[j]; nxt[(rx + 32) * 68 + col] = sy[j]; }
        __syncthreads(); };
    constexpr int NFULL = NCHUNK / PD * PD;
#pragma unroll 1
    for (int c0 = 0; c0 < NFULL; c0 += PD) {
#pragma unroll
        for (int d = 0; d < PD; ++d) step(c0 + d, pb[d], ub[d]);
    }
#pragma unroll
    for (int d = 0; d < NCHUNK - NFULL; ++d) step(NFULL + d, pb[d], ub[d]);
    { const LAS float* fin = sS + (NCHUNK & 1) * 4352; float* o = X.out + O_RWP + (size_t)h * 4096;
      for (int i = X.tid; i < 4096; i += 512) o[i] = fin[(i >> 6) * 68 + (i & 63)]; }
}

__device__ __forceinline__ void scan_c_finish(float o, const LAS float* st, float lw, float lb, int lane, bf16_t* dst) {
    const float mean = wave_sum(o) * (1.f / 64.f), d = o - mean, var = wave_sum(d * d) * (1.f / 64.f);
    const float on = d * rsqrtf(var + 64e-5f) * lw + lb;
    const float vi = st[320 + lane], g = st[384 + lane], bon = st[448];
    *dst = f2bf((on + bon * vi) * g);
}
__device__ __forceinline__ void phase_scan_c(const Ctx& X) {
    LAS float* wl = (LAS float*)(X.lds + X.wave * SCAN_WLDS);
    const float* SC = X.W<float>(WS_SC); bf16_t* OC = X.W<bf16_t>(WS_OCAT);
    int lane = X.lane; asm volatile("" : "+v"(lane));
    for (int id = X.bid * 8 + X.wave; id < NCHUNK * 32 + DEC_B * 32; id += X.G * 8) {
        const bool smp = id >= NCHUNK * 32; const int task = smp ? id - NCHUNK * 32 : id, cb = task >> 5, h = task & 31;
        const int tok0 = smp ? SEQ + cb * 8 : cb * CHUNK, nsb = smp ? 1 : CHUNK / 8;
        float S[64];
        if (smp) { const float* s0 = X.in[I_SRW] + ((size_t)(cb * 32 + h) * 64 + lane) * 64;
#pragma unroll
            for (int q = 0; q < 16; ++q) { const f32x4 v = *(const f32x4*)(s0 + 4 * q); S[4 * q] = v[0]; S[4 * q + 1] = v[1]; S[4 * q + 2] = v[2]; S[4 * q + 3] = v[3]; }
        } else if (cb > 0) { const float* s0 = SC + (size_t)(cb * 32 + h) * 4096 + lane;
#pragma unroll
            for (int j = 0; j < 64; ++j) S[j] = s0[j * 64];
        } else {
#pragma unroll
            for (int j = 0; j < 64; ++j) S[j] = 0.f; }
        const float lw = X.in[I_LNW][h * 64 + lane], lb = X.in[I_LNB][h * 64 + lane];
        if (smp) {
            ScanRegs R; scan_load(X, R, tok0, h, lane, true, true, true);
            scan_store(wl, R, lane, true, true, true);
            wave_sync();
#pragma unroll 1
            for (int s = 0; s < 8; ++s) { const float o = scan_step<true, true>(S, wl + s * SCAN_STEP, lane);
                scan_c_finish(o, wl + s * SCAN_STEP, lw, lb, lane, OC + (size_t)(tok0 + s) * 4096 + h * 64 + lane); }
            wave_sync();
            float* dst = X.out + O_RWS + ((size_t)(cb * 32 + h) * 64 + lane) * 64;
#pragma unroll
            for (int q = 0; q < 16; ++q) *(f32x4*)(dst + 4 * q) = (f32x4){S[4 * q], S[4 * q + 1], S[4 * q + 2], S[4 * q + 3]};
        } else {
            u32x4 rq, ru, rv, rg; float rb;
            auto ld = [&](int t0) { const size_t off = (size_t)(t0 + (lane >> 3)) * DM + h * 64 + (lane & 7) * 8;
                rq = *(const u32x4*)(X.W<unsigned>(WS_QV) + off); ru = *(const u32x4*)(X.W<unsigned>(WS_QV) + off + 4); rv = *(const u32x4*)(X.W<bf16_t>(WS_VS) + off); rg = *(const u32x4*)(X.W<bf16_t>(WS_GG) + off);
                rb = X.W<float>(WS_BON)[(size_t)(t0 + (lane & 7)) * 32 + h]; };
            ld(tok0);
            for (int sb = 0; sb < nsb; ++sb) {
                { LAS float* base = wl + (lane >> 3) * SCAN_STEP + (lane & 7) * 8; float f[8];
                  *(LAS f32x4*)(base) = (f32x4){bf_lo(rq.x), bf_lo(rq.y), bf_lo(rq.z), bf_lo(rq.w)}; *(LAS f32x4*)(base + 4) = (f32x4){bf_lo(ru.x), bf_lo(ru.y), bf_lo(ru.z), bf_lo(ru.w)};
                  *(LAS f32x4*)(base + 256) = (f32x4){bf_hi(rq.x), bf_hi(rq.y), bf_hi(rq.z), bf_hi(rq.w)}; *(LAS f32x4*)(base + 260) = (f32x4){bf_hi(ru.x), bf_hi(ru.y), bf_hi(ru.z), bf_hi(ru.w)};
                  unpack8(rv, f); *(LAS f32x4*)(base + 320) = (f32x4){f[0], f[1], f[2], f[3]}; *(LAS f32x4*)(base + 324) = (f32x4){f[4], f[5], f[6], f[7]};
                  unpack8(rg, f); *(LAS f32x4*)(base + 384) = (f32x4){f[0], f[1], f[2], f[3]}; *(LAS f32x4*)(base + 388) = (f32x4){f[4], f[5], f[6], f[7]};
                  if (lane < 8) wl[lane * SCAN_STEP + 448] = rb; }
                wave_sync();
                if (sb + 1 < nsb) ld(tok0 + 8 * (sb + 1));
#pragma unroll 1
                for (int s = 0; s < 8; ++s) { const LAS float* st = wl + s * SCAN_STEP; const LAS f32x4* Q4 = (const LAS f32x4*)st;
                    float o0 = 0.f, o1 = 0.f, o2 = 0.f, o3 = 0.f;
#pragma unroll
                    for (int q = 0; q < 16; ++q) { const f32x4 qv = Q4[q]; o0 = fmaf(S[4 * q], qv[0], o0); o1 = fmaf(S[4 * q + 1], qv[1], o1); o2 = fmaf(S[4 * q + 2], qv[2], o2); o3 = fmaf(S[4 * q + 3], qv[3], o3); }
                    const float o = ((o0 + o1) + (o2 + o3)) + st[256 + lane];
                    scan_c_finish(o, st, lw, lb, lane, OC + (size_t)(tok0 + 8 * sb + s) * 4096 + h * 64 + lane); }
                wave_sync();
            }
        }
    }
}

__device__ __forceinline__ unsigned okey(float f) { const unsigned u = __float_as_uint(f); return (u & 0x80000000u) ? ~u : (u | 0x80000000u); }
constexpr int IDX_HIST = 131072, IDX_MISC = LDS_MISC + 256, IDX_LIST = LDS_MISC + 1024;
template <int NQ, bool SAMPLE>
__device__ __forceinline__ void indexer_task(const Ctx& X, int task) {
    constexpr int SCLD = SAMPLE ? 2064 : 8192, WPQ = 8 / NQ, TPQ = 64 * WPQ;
    int lane = X.lane; asm volatile("" : "+v"(lane));
    const int wave = X.wave, tid = wave * 64 + lane, fr = lane & 15, fq = lane >> 4;
    const bf16_t* Z = X.W<bf16_t>(WS_Z); const bf16_t* KIB = X.W<bf16_t>(WS_KIB); const float* WI = X.W<float>(WS_WI);
    LAS float* sc = (LAS float*)X.lds;
    const int tokbase = SAMPLE ? SEQ + task * 8 : task * 4;
#ifdef STAMP_BUILD
    unsigned long long* stw = X.W<unsigned long long>(WS_CTL) + 16384 + 40 + (SAMPLE ? 2 : 0); const bool stamper = (X.bid == 0 && tid == 0);
    const unsigned long long ts0 = wall_clock64();
#endif
    if constexpr (!SAMPLE) {
        const int c32 = lane & 31, hf = lane >> 5;
        bf16x8 Aq[2][4]; float wv[2][16];
#pragma unroll
        for (int p = 0; p < 2; ++p) {
            const int qrow = tokbase + 2 * p + ((c32 >> 2) & 1), head = (c32 & 3) + 4 * (c32 >> 3);
            const bf16_t* zq = Z + (size_t)qrow * ZLD + C_QI + head * 64 + hf * 8;
#pragma unroll
            for (int ks = 0; ks < 4; ++ks) Aq[p][ks] = *(const bf16x8*)(zq + 16 * ks);
            const float* wp = WI + (size_t)(tokbase + 2 * p + hf) * 16;
#pragma unroll
            for (int i4 = 0; i4 < 4; ++i4) { const f32x4 v = *(const f32x4*)(wp + 4 * i4); wv[p][4 * i4] = v[0]; wv[p][4 * i4 + 1] = v[1]; wv[p][4 * i4 + 2] = v[2]; wv[p][4 * i4 + 3] = v[3]; }
        }
        const int nkt = (tokbase + 4 + 31) >> 5;
        float smx[2] = {-__builtin_inff(), -__builtin_inff()}, smn[2] = {__builtin_inff(), __builtin_inff()};
        const unsigned char* kbase = X.ws + WS_KIB; const unsigned klane = (unsigned)(lane * 16);
        constexpr int KU = 8;
        for (int kt0 = wave * KU; kt0 < nkt; kt0 += 8 * KU) {
            bf16x8 kb[KU][4];
#pragma unroll
            for (int u = 0; u < KU; ++u) { const int kt = kt0 + u; const unsigned char* kr = kbase + (size_t)(kt < nkt ? kt : nkt - 1) * 4096;
#pragma unroll
                for (int ks = 0; ks < 4; ++ks) kb[u][ks] = *(const bf16x8*)(kr + (klane + 1024u * ks)); }
#pragma unroll
            for (int u = 0; u < KU; ++u) {
                const int kt = kt0 + u, key = kt * 32 + c32;
#pragma unroll
                for (int p = 0; p < 2; ++p) {
                    f32x16 acc;
#pragma unroll
                    for (int i = 0; i < 16; ++i) acc[i] = 0.f;
#pragma unroll
                    for (int ks = 0; ks < 4; ++ks) acc = __builtin_amdgcn_mfma_f32_32x32x16_bf16(Aq[p][ks], kb[u][ks], acc, 0, 0, 0);
                    float s0 = 0.f, s1 = 0.f;
#pragma unroll
                    for (int i = 0; i < 16; i += 2) { s0 = fmaf(wv[p][i], fmaxf(acc[i], 0.f), s0); s1 = fmaf(wv[p][i + 1], fmaxf(acc[i + 1], 0.f), s1); }
                    const float sv = s0 + s1;
                    if (kt * 32 + 31 <= tokbase) { sc[(2 * p + hf) * SCLD + key] = sv; smx[p] = fmaxf(smx[p], sv); smn[p] = fminf(smn[p], sv); }
                    else if (kt < nkt && key <= tokbase + 2 * p + hf) { sc[(2 * p + hf) * SCLD + key] = sv; smx[p] = fmaxf(smx[p], sv); smn[p] = fminf(smn[p], sv); }
                }
            }
        }
        LAS unsigned* mm = (LAS unsigned*)(X.lds + IDX_MISC);
#pragma unroll
        for (int p = 0; p < 2; ++p) { __hip_atomic_fetch_max(&mm[2 * (2 * p + hf)], okey(smx[p]), __ATOMIC_RELAXED, __HIP_MEMORY_SCOPE_WORKGROUP);
                                      __hip_atomic_fetch_min(&mm[2 * (2 * p + hf) + 1], okey(smn[p]), __ATOMIC_RELAXED, __HIP_MEMORY_SCOPE_WORKGROUP); }
    } else {
    bf16x8 Af[NQ][2]; float wq[NQ];
#pragma unroll
    for (int qq = 0; qq < NQ; ++qq) { const bf16_t* zq = Z + (size_t)(tokbase + qq) * ZLD + C_QI + fr * 64 + fq * 8;
        Af[qq][0] = *(const bf16x8*)zq; Af[qq][1] = *(const bf16x8*)(zq + 32);
        wq[qq] = WI[(size_t)(tokbase + qq) * 16 + fr]; }
    const int nkeys = SAMPLE ? PAST + 8 : tokbase + 4, nkt = (nkeys + 15) >> 4;
    constexpr int KU = SAMPLE ? 4 : 8;
    for (int kt0 = wave * KU; kt0 < nkt; kt0 += 8 * KU) {
        bf16x8 b0[KU], b1[KU];
#pragma unroll
        for (int u = 0; u < KU; ++u) {
            const int kt = kt0 + u, key = (kt < nkt ? kt : nkt - 1) * 16 + fr;
            if (!SAMPLE || key >= PAST) {
                const int krow = SAMPLE ? SEQ + task * 8 + (key - PAST) : key;
                if (!SAMPLE || key < PAST + 8) { const unsigned char* kr = (const unsigned char*)KIB + (size_t)(krow >> 5) * 4096 + (fq >> 1) * 1024 + ((krow & 31) + 32 * (fq & 1)) * 16;
                    b0[u] = *(const bf16x8*)kr; b1[u] = *(const bf16x8*)(kr + 2048); }
                else { b0[u] = (bf16x8){0, 0, 0, 0, 0, 0, 0, 0}; b1[u] = b0[u]; }
            } else {
                const int page = ((const int*)X.in[I_PT])[task * NPAGES + (key >> 7)];
                const float* kr = X.in[I_CKI] + ((size_t)page * PAGE + (key & 127)) * 64 + fq * 8;
                const f32x4 x0 = *(const f32x4*)kr, x1 = *(const f32x4*)(kr + 4), y0 = *(const f32x4*)(kr + 32), y1 = *(const f32x4*)(kr + 36);
                u32x4 w0, w1; w0.x = cvt_pk_bf16(x0[0], x0[1]); w0.y = cvt_pk_bf16(x0[2], x0[3]); w0.z = cvt_pk_bf16(x1[0], x1[1]); w0.w = cvt_pk_bf16(x1[2], x1[3]);
                w1.x = cvt_pk_bf16(y0[0], y0[1]); w1.y = cvt_pk_bf16(y0[2], y0[3]); w1.z = cvt_pk_bf16(y1[0], y1[1]); w1.w = cvt_pk_bf16(y1[2], y1[3]);
                b0[u] = __builtin_bit_cast(bf16x8, w0); b1[u] = __builtin_bit_cast(bf16x8, w1);
            }
        }
#pragma unroll
        for (int u = 0; u < KU; ++u) {
            const int kt = kt0 + u;
#pragma unroll
            for (int qq = 0; qq < NQ; ++qq) {
                f32x4 acc = {0.f, 0.f, 0.f, 0.f};
                acc = __builtin_amdgcn_mfma_f32_16x16x32_bf16(b0[u], Af[qq][0], acc, 0, 0, 0);
                acc = __builtin_amdgcn_mfma_f32_16x16x32_bf16(b1[u], Af[qq][1], acc, 0, 0, 0);
                const float s0 = row16_sum(wq[qq] * fmaxf(acc[0], 0.f)), s1 = row16_sum(wq[qq] * fmaxf(acc[1], 0.f)), s2 = row16_sum(wq[qq] * fmaxf(acc[2], 0.f)), s3 = row16_sum(wq[qq] * fmaxf(acc[3], 0.f));
                const float sv = fr == 0 ? s0 : (fr == 1 ? s1 : (fr == 2 ? s2 : s3));
                const int key = kt * 16 + 4 * fq + fr, lim = SAMPLE ? PAST + qq : tokbase + qq;
                if (fr < 4 && kt < nkt && key <= lim) sc[qq * SCLD + key] = sv;
            }
        }
    }
    }
    __syncthreads();
#ifdef STAMP_BUILD
    const unsigned long long ts1 = wall_clock64();
#endif
    {
        constexpr int CAPC = SAMPLE ? 384 : 768, NCOPY = 16 / NQ, WPQ = SAMPLE ? 1 : 2;
        const int qq = SAMPLE ? wave : (wave & (NQ - 1)), role = SAMPLE ? 0 : (wave / NQ);
        const int n = SAMPLE ? PAST + 1 + qq : tokbase + qq + 1, nsel = n < 256 ? n : 256;
        int* idxo = X.W<int>(WS_IDX) + (size_t)(tokbase + qq) * 256;
        const LAS float* scq = sc + qq * SCLD;
        LAS unsigned* hist = (LAS unsigned*)(X.lds + IDX_HIST) + qq * (NCOPY * 256);
        LAS unsigned short* list = (LAS unsigned short*)(X.lds + IDX_LIST) + qq * CAPC;
        auto sync = [&]() { if constexpr (SAMPLE) wave_sync(); else __syncthreads(); };
        if (role == 0 && lane == 0) X.W<int>(WS_NSEL)[tokbase + qq] = nsel;
        const int n4 = n >> 2, ntail = n & 3, gmid = (WPQ == 2) ? (n4 >> 1) : n4;
        const int glo = role == 0 ? 0 : gmid, ghi = (role == WPQ - 1) ? n4 : gmid; const bool dotail = (role == WPQ - 1) && ntail;
        auto sweep = [&](auto&& f) {
#pragma unroll 2
            for (int g0 = glo; g0 < ghi; g0 += 64) { const int g = g0 + lane; const bool ok = g < ghi; const f32x4 v = *(const LAS f32x4*)(scq + 4 * (ok ? g : 0));
#pragma unroll
                for (int e = 0; e < 4; ++e) f(v[e], 4 * g + e, ok); }
            if (dotail) { const bool ok = lane < ntail; const int idx = 4 * n4 + (ok ? lane : 0); f(scq[idx], idx, ok); } };
        float hif = -__builtin_inff(), lof = __builtin_inff();
        if (n > 256) {
            if constexpr (SAMPLE) {
                sweep([&](float v, int, bool ok) { if (ok) { hif = fmaxf(hif, v); lof = fminf(lof, v); } });
#pragma unroll
                for (int d = 1; d < 64; d <<= 1) { hif = fmaxf(hif, __shfl_xor(hif, d)); lof = fminf(lof, __shfl_xor(lof, d)); }
            } else {
                const LAS unsigned* mm = (const LAS unsigned*)(X.lds + IDX_MISC) + 2 * qq;
                const unsigned uh = mm[0], ul = mm[1];
                hif = __uint_as_float((uh & 0x80000000u) ? (uh ^ 0x80000000u) : ~uh); lof = __uint_as_float((ul & 0x80000000u) ? (ul ^ 0x80000000u) : ~ul);
            }
        }
        const int mode = n <= 256 ? 0 : (hif == lof ? 1 : 2);
        if (mode < 2 && role == 0) { for (int i = lane; i < nsel; i += 64) idxo[i] = i; }
        const float scale = 256.f / (hif - lof);
        auto lbin = [&](float v) { const unsigned b = (unsigned)((v - lof) * scale); return b > 255u ? 255u : b; };
        const int rot = lane & (NCOPY - 1); LAS unsigned* hme = hist + rot * 256; const unsigned radd = 16u * rot;
        auto zero_hist = [&]() { for (int i = lane; i < NCOPY * 64; i += 64) *(LAS u32x4*)(hist + 4 * i) = (u32x4){0u, 0u, 0u, 0u}; };
        auto find_bin = [&](unsigned kneed, unsigned& bin, unsigned& above, unsigned& own) {
            unsigned c0 = 0, c1 = 0, c2 = 0, c3 = 0;
#pragma unroll
            for (int cp = 0; cp < NCOPY; ++cp) { const LAS unsigned* h = hist + cp * 256; const int r = 16 * cp;
                c0 += h[(255 - 4 * lane + r) & 255]; c1 += h[(254 - 4 * lane + r) & 255]; c2 += h[(253 - 4 * lane + r) & 255]; c3 += h[(252 - 4 * lane + r) & 255]; }
            const unsigned tot = c0 + c1 + c2 + c3; unsigned incl = tot;
#pragma unroll
            for (int d = 1; d < 64; d <<= 1) { const unsigned v = __shfl_up(incl, d); if (lane >= d) incl += v; }
            const unsigned long long m = __ballot(incl >= kneed);
            const int L = m ? (__ffsll((long long)m) - 1) : 63;
            unsigned ab = incl - tot, cs; int bn;
            if (ab + c0 >= kneed) { bn = 255 - 4 * lane; cs = c0; } else { ab += c0;
            if (ab + c1 >= kneed) { bn = 254 - 4 * lane; cs = c1; } else { ab += c1;
            if (ab + c2 >= kneed) { bn = 253 - 4 * lane; cs = c2; } else { ab += c2; bn = 252 - 4 * lane; cs = c3; } } }
            bin = (unsigned)__shfl(bn, L); above = __shfl(ab, L); own = __shfl(cs, L); };
        if (mode == 2 && role == 0) zero_hist();
        sync();
        if (mode == 2) sweep([&](float v, int, bool ok) { if (ok) __hip_atomic_fetch_add(&hme[(lbin(v) + radd) & 255u], 1u, __ATOMIC_RELAXED, __HIP_MEMORY_SCOPE_WORKGROUP); });
        sync();
        unsigned B = 0u, above = 0u, cB = 0u, kneed = 256u;
        if (mode == 2) {
            find_bin(kneed, B, above, cB); kneed -= above;
            const bool uselist = cB <= (unsigned)CAPC;
            unsigned scnt = 0u, ccnt = 0u;
            sweep([&](float v, int idx, bool ok) { const unsigned dg = lbin(v); const bool sel = ok && dg > B, cand = ok && dg == B;
                const unsigned long long m1 = __ballot(sel), m2 = __ballot(cand);
                if (sel) { const unsigned k = scnt + __builtin_amdgcn_mbcnt_hi((unsigned)(m1 >> 32), __builtin_amdgcn_mbcnt_lo((unsigned)m1, 0u)); idxo[role == 0 ? k : above - 1u - k] = idx; }
                if (cand && uselist) { const unsigned k = ccnt + __builtin_amdgcn_mbcnt_hi((unsigned)(m2 >> 32), __builtin_amdgcn_mbcnt_lo((unsigned)m2, 0u)); list[role == 0 ? k : cB - 1u - k] = (unsigned short)idx; }
                scnt += (unsigned)__popcll(m1); ccnt += (unsigned)__popcll(m2); });
        }
        sync();
        if (mode == 2 && role == 0) {
            unsigned base = above;
            const bool uselist = cB <= (unsigned)CAPC; const int m = uselist ? (int)cB : n;
            auto csweep = [&](auto&& f) {
                for (int j0 = 0; j0 < m; j0 += 64) { const int j = j0 + lane; const bool in = j < m; const int idx = uselist ? (int)list[in ? j : 0] : (in ? j : 0);
                    const float v = scq[idx]; f(okey(v), idx, in && (uselist || lbin(v) == B)); } };
            unsigned hi = 0u, lo = 0xFFFFFFFFu;
            csweep([&](unsigned u, int, bool ok) { if (ok) { hi = u > hi ? u : hi; lo = u < lo ? u : lo; } });
#pragma unroll
            for (int d = 1; d < 64; d <<= 1) { const unsigned x = __shfl_xor(hi, d), y = __shfl_xor(lo, d); hi = x > hi ? x : hi; lo = y < lo ? y : lo; }
            hi = __builtin_amdgcn_readfirstlane(hi); lo = __builtin_amdgcn_readfirstlane(lo);
            int top = (hi == lo) ? 0 : 32 - __clz(hi ^ lo);
            unsigned prefix = top >= 32 ? 0u : ((hi >> top) << top);
            while (top > 0) {
                const int s2 = top > 8 ? top - 8 : 0; const unsigned dmask = (1u << (top - s2)) - 1u;
                zero_hist(); wave_sync();
                csweep([&](unsigned u, int, bool ok) { if (ok && (top >= 32 || (u >> top) == (prefix >> top))) __hip_atomic_fetch_add(&hme[(((u >> s2) & dmask) + radd) & 255u], 1u, __ATOMIC_RELAXED, __HIP_MEMORY_SCOPE_WORKGROUP); });
                wave_sync();
                unsigned B2, ab2, own2; find_bin(kneed, B2, ab2, own2); kneed -= ab2; prefix |= B2 << s2; top = s2;
            }
            unsigned ties = 0u;
            csweep([&](unsigned u, int idx, bool ok) { const bool sel = ok && u > prefix, tie = ok && u == prefix;
                const unsigned long long m1 = __ballot(sel), m2 = __ballot(tie);
                if (sel) idxo[base + __builtin_amdgcn_mbcnt_hi((unsigned)(m1 >> 32), __builtin_amdgcn_mbcnt_lo((unsigned)m1, 0u))] = idx;
                base += (unsigned)__popcll(m1);
                if (tie) { const unsigned e = ties + __builtin_amdgcn_mbcnt_hi((unsigned)(m2 >> 32), __builtin_amdgcn_mbcnt_lo((unsigned)m2, 0u)); if (e < kneed) idxo[255u - e] = idx; }
                ties += (unsigned)__popcll(m2); });
        }
    }
    __syncthreads();
#ifdef STAMP_BUILD
    if (stamper) { const unsigned long long ts2 = wall_clock64(); stw[0] += ts1 - ts0; stw[1] += ts2 - ts1; }
#endif
}
constexpr int CW_IDXQ = 20480;
__device__ __forceinline__ void phase_index(const Ctx& X) {
    const int npr = SEQ / 4, ntask = DEC_B + npr;
    unsigned* head = X.W<unsigned>(WS_CTL) + CW_IDXQ;
    LAS unsigned* slot = (LAS unsigned*)(X.lds + LDS_MISC + 512);
    for (;;) {
        if (X.tid == 0) *slot = __hip_atomic_fetch_add(head, 1u, __ATOMIC_RELAXED, __HIP_MEMORY_SCOPE_AGENT);
        __syncthreads();
        const int k = (int)*slot;
        if (X.tid < 8) ((LAS unsigned*)(X.lds + IDX_MISC))[X.tid] = (X.tid & 1) ? 0xFFFFFFFFu : 0u;
        __syncthreads();
        if (k >= ntask) break;
        if (k < DEC_B) indexer_task<8, true>(X, k); else indexer_task<4, false>(X, npr - 1 - (k - DEC_B));
    }
}

constexpr int ATT_WLDS = SCAN_WLDS;
static_assert(4096 + 4096 + 2048 <= SCAN_WLDS, "attention scratch must fit the per-wave scan region");
__device__ __forceinline__ void attn_task_smp(const Ctx& X, int t, int n) {
    constexpr int TG = 4, PU = 12;
    int lane = X.lane; asm volatile("" : "+v"(lane));
    const int fr = lane & 15, fq = lane >> 4;
    LAS float* lg = (LAS float*)(X.lds + X.wave * ATT_WLDS);
    LAS float* pT = lg + 1024;
    LAS int* lidx = (LAS int*)(pT + 1024);
    const bf16_t* QB = X.W<bf16_t>(WS_QB);
    const int ns = X.W<int>(WS_NSEL)[t];
    const int* idxg = X.W<int>(WS_IDX) + (size_t)t * 256;
    const int b = (t - SEQ) >> 3;
    const int* pt = (const int*)X.in[I_PT] + b * NPAGES;
#pragma unroll
    for (int i = 0; i < 4; ++i) { const int s = lane + 64 * i; int v = 0;
        if (s < ns) { const int pos = idxg[s]; v = pos >= PAST ? pos - PAST : -(pt[pos >> 7] * PAGE + (pos & 127) + 1); }
        lidx[s] = v; }
    const float* knew = X.out + O_KS + (size_t)b * 8 * 512 + n * 128; const float* vnew = X.out + O_VS + (size_t)b * 8 * 512 + n * 128;
    const float* kch = X.in[I_CK] + n * 128; const float* vch = X.in[I_CV] + n * 128;
    bf16x8 Aq[4];
#pragma unroll
    for (int ks = 0; ks < 4; ++ks) { if (fr < 4) Aq[ks] = *(const bf16x8*)(QB + (size_t)t * DM + (4 * n + fr) * 128 + ks * 32 + fq * 8); else Aq[ks] = (bf16x8){0, 0, 0, 0, 0, 0, 0, 0}; }
    wave_sync();
    const int ntile = (ns + 15) >> 4;
    for (int kt0 = 0; kt0 < ntile; kt0 += TG) {
        f32x4 kx[TG][4][2];
#pragma unroll
        for (int g = 0; g < TG; ++g) {
            const int s = (kt0 + g) * 16 + fr; const int row = (kt0 + g < ntile) ? lidx[s] : 0;
            const float* kr = (row >= 0 ? knew + (size_t)row * 512 : kch + (size_t)(-row - 1) * 512) + fq * 8;
#pragma unroll
            for (int ks = 0; ks < 4; ++ks) { kx[g][ks][0] = *(const f32x4*)(kr + ks * 32); kx[g][ks][1] = *(const f32x4*)(kr + ks * 32 + 4); }
        }
#pragma unroll
        for (int g = 0; g < TG; ++g) {
            f32x4 acc = {0.f, 0.f, 0.f, 0.f};
#pragma unroll
            for (int ks = 0; ks < 4; ++ks) { const f32x4 x0 = kx[g][ks][0], x1 = kx[g][ks][1];
                u32x4 w; w.x = cvt_pk_bf16(x0[0], x0[1]); w.y = cvt_pk_bf16(x0[2], x0[3]); w.z = cvt_pk_bf16(x1[0], x1[1]); w.w = cvt_pk_bf16(x1[2], x1[3]);
                acc = __builtin_amdgcn_mfma_f32_16x16x32_bf16(Aq[ks], __builtin_bit_cast(bf16x8, w), acc, 0, 0, 0); }
            if (fq == 0 && kt0 + g < ntile) { const int s = (kt0 + g) * 16 + fr;
#pragma unroll
                for (int j = 0; j < 4; ++j) lg[j * 256 + s] = acc[j]; }
        }
    }
    wave_sync();
    {
        float l[16], m = -1e30f;
#pragma unroll
        for (int i = 0; i < 16; ++i) { const int s = fr * 16 + i; l[i] = (s < ns) ? lg[fq * 256 + s] : -1e30f; m = fmaxf(m, l[i]); }
        m = row16_max(m);
        float sum = 0.f;
#pragma unroll
        for (int i = 0; i < 16; ++i) { const int s = fr * 16 + i; const float e = (s < ns) ? __expf(l[i] - m) : 0.f; l[i] = e; sum += e; }
        sum = row16_sum(sum); const float inv = 1.f / sum;
#pragma unroll
        for (int i = 0; i < 16; ++i) pT[(fr * 16 + i) * 4 + fq] = l[i] * inv;
    }
    wave_sync();
    float acc[4][8];
#pragma unroll
    for (int hh = 0; hh < 4; ++hh)
#pragma unroll
        for (int d = 0; d < 8; ++d) acc[hh][d] = 0.f;
    const int nit = (ns + 3) >> 2;
    for (int it0 = 0; it0 < nit; it0 += PU) {
        f32x4 vx[PU][2];
#pragma unroll
        for (int u = 0; u < PU; ++u) { const int s = (it0 + u) * 4 + fq; const int row = (it0 + u < nit) ? lidx[s] : 0;
            const float* vr = (row >= 0 ? vnew + (size_t)row * 512 : vch + (size_t)(-row - 1) * 512) + fr * 8; vx[u][0] = *(const f32x4*)vr; vx[u][1] = *(const f32x4*)(vr + 4); }
#pragma unroll
        for (int u = 0; u < PU; ++u) { const int s = (it0 + u) * 4 + fq;
            f32x4 p4 = {0.f, 0.f, 0.f, 0.f}; if (it0 + u < nit) p4 = *(const LAS f32x4*)(pT + s * 4);
#pragma unroll
            for (int hh = 0; hh < 4; ++hh) {
#pragma unroll
                for (int d = 0; d < 4; ++d) { acc[hh][d] = fmaf(p4[hh], vx[u][0][d], acc[hh][d]); acc[hh][4 + d] = fmaf(p4[hh], vx[u][1][d], acc[hh][4 + d]); } }
        }
    }
#pragma unroll
    for (int hh = 0; hh < 4; ++hh)
#pragma unroll
        for (int d = 0; d < 8; ++d) { float a = acc[hh][d]; a += __shfl_xor(a, 16); a += __shfl_xor(a, 32); acc[hh][d] = a; }
    if (fq == 0) { bf16_t* op = X.W<bf16_t>(WS_OCAT) + (size_t)t * 4096 + 2048 + (4 * n) * 128 + fr * 8;
#pragma unroll
        for (int hh = 0; hh < 4; ++hh) *(u32x4*)(op + hh * 128) = pack8(acc[hh]); }
    wave_sync();
}
struct AttnPre { int ns; int idx[4]; };
struct AttnCur { int t, ns; long Aq[4]; u32x4 Bk[8][2]; };
__device__ __forceinline__ void attn_prefetch(const Ctx& X, int t, AttnPre& P) {
    int lane = X.lane; asm volatile("" : "+v"(lane));
    P.ns = X.W<int>(WS_NSEL)[t]; const unsigned char* ib = X.ws + WS_IDX + (size_t)t * 1024;
#pragma unroll
    for (int i = 0; i < 4; ++i) P.idx[i] = *(const int*)(ib + (unsigned)(lane * 4 + 256 * i));
}
__device__ __forceinline__ void attn_stage(const Ctx& X, int t, int n, const AttnPre& P, LAS int* lidx, AttnCur& C) {
    int lane = X.lane; asm volatile("" : "+v"(lane));
    const int fr = lane & 15, fq = lane >> 4;
    C.t = t; C.ns = P.ns;
#pragma unroll
    for (int i = 0; i < 4; ++i) { const int s = lane + 64 * i; lidx[s] = (s < P.ns) ? P.idx[i] : 0; }
    const unsigned char* Q8 = X.W<unsigned char>(WS_Q8) + (size_t)t * DM + (4 * n) * 128; const unsigned char* K8 = X.W<unsigned char>(WS_K8) + (size_t)n * (SEQ * 128);
#pragma unroll
    for (int ks = 0; ks < 4; ++ks) C.Aq[ks] = (fr < 4) ? *(const long*)(Q8 + (unsigned)(fr * 128 + ks * 32 + fq * 8)) : 0L;
    wave_sync();
#pragma unroll
    for (int g = 0; g < 8; ++g) { const unsigned ko = (unsigned)(lidx[g * 16 + fr] * 128 + fq * 16); C.Bk[g][0] = *(const u32x4*)(K8 + ko); C.Bk[g][1] = *(const u32x4*)(K8 + (ko + 64u)); }
}
__device__ __forceinline__ void attn_run8(const Ctx& X, int n, AttnCur& C, LAS int* lidx, int tnext, const AttnPre& P, LAS int* lidxn, AttnCur& Cn) {
    constexpr int PU = 8;
    int lane = X.lane; asm volatile("" : "+v"(lane));
    const int fr = lane & 15, fq = lane >> 4;
    LAS float* lg = (LAS float*)(X.lds + X.wave * ATT_WLDS);
    LAS float* pT = lg + 1024;
    const unsigned char* K8 = X.W<unsigned char>(WS_K8) + (size_t)n * (SEQ * 128); const unsigned char* V8 = X.W<unsigned char>(WS_V8) + (size_t)n * (SEQ * 128);
    const int t = C.t, ns = C.ns;
    u32x4 Bk1[8][2];
#pragma unroll
    for (int g = 0; g < 8; ++g) { const unsigned ko = (unsigned)(lidx[128 + g * 16 + fr] * 128 + fq * 16); Bk1[g][0] = *(const u32x4*)(K8 + ko); Bk1[g][1] = *(const u32x4*)(K8 + (ko + 64u)); }
    auto qk = [&](const u32x4 (&Bk)[8][2], int g0) {
#pragma unroll
        for (int g = 0; g < 8; ++g) {
            f32x4 acc = {0.f, 0.f, 0.f, 0.f};
            const long b0 = (long)(((unsigned long long)Bk[g][0].y << 32) | Bk[g][0].x), b1 = (long)(((unsigned long long)Bk[g][0].w << 32) | Bk[g][0].z),
                       b2 = (long)(((unsigned long long)Bk[g][1].y << 32) | Bk[g][1].x), b3 = (long)(((unsigned long long)Bk[g][1].w << 32) | Bk[g][1].z);
            acc = __builtin_amdgcn_mfma_f32_16x16x32_fp8_fp8(C.Aq[0], b0, acc, 0, 0, 0); acc = __builtin_amdgcn_mfma_f32_16x16x32_fp8_fp8(C.Aq[1], b1, acc, 0, 0, 0);
            acc = __builtin_amdgcn_mfma_f32_16x16x32_fp8_fp8(C.Aq[2], b2, acc, 0, 0, 0); acc = __builtin_amdgcn_mfma_f32_16x16x32_fp8_fp8(C.Aq[3], b3, acc, 0, 0, 0);
            if (fq == 0) { const int s = (g0 + g) * 16 + fr;
#pragma unroll
                for (int j = 0; j < 4; ++j) lg[j * 256 + s] = acc[j] * 0.08838834764831845f; }
        } };
    qk(C.Bk, 0);
    qk(Bk1, 8);
    u32x2 r0[PU], r1[PU], r2[PU];
    auto vload = [&](u32x2 (&v)[PU], int it0) {
#pragma unroll
        for (int u = 0; u < PU; ++u) v[u] = *(const u32x2*)(V8 + (unsigned)(lidx[(it0 + u) * 4 + fq] * 128 + fr * 8)); };
    vload(r0, 0); vload(r1, PU);
    wave_sync();
    {
        float l[16], m = -1e30f;
#pragma unroll
        for (int i = 0; i < 16; ++i) { const int s = fr * 16 + i; l[i] = (s < ns) ? lg[fq * 256 + s] : -1e30f; m = fmaxf(m, l[i]); }
        m = row16_max(m);
        float sum = 0.f;
#pragma unroll
        for (int i = 0; i < 16; ++i) { const int s = fr * 16 + i; const float e = (s < ns) ? __expf(l[i] - m) : 0.f; l[i] = e; sum += e; }
        sum = row16_sum(sum); const float inv = 1.f / sum;
#pragma unroll
        for (int i = 0; i < 16; ++i) pT[(fr * 16 + i) * 4 + fq] = l[i] * inv;
    }
    wave_sync();
    attn_stage(X, tnext >= 0 ? tnext : t, n, P, lidxn, Cn);
    float acc[4][8];
#pragma unroll
    for (int hh = 0; hh < 4; ++hh)
#pragma unroll
        for (int d = 0; d < 8; ++d) acc[hh][d] = 0.f;
    auto vfma = [&](const u32x2 (&vr)[PU], int it0) {
        f32x4 pc = *(const LAS f32x4*)(pT + (it0 * 4 + fq) * 4);
#pragma unroll
        for (int u = 0; u < PU; ++u) {
            u32x2 w = vr[u];
            asm volatile("" : "+v"(w.x), "+v"(acc[0][0]), "+v"(acc[0][1]), "+v"(acc[0][2]), "+v"(acc[0][3]), "+v"(acc[0][4]), "+v"(acc[0][5]), "+v"(acc[0][6]), "+v"(acc[0][7]),
                              "+v"(acc[1][0]), "+v"(acc[1][1]), "+v"(acc[1][2]), "+v"(acc[1][3]), "+v"(acc[1][4]), "+v"(acc[1][5]), "+v"(acc[1][6]), "+v"(acc[1][7]) :: "memory");
            asm volatile("" : "+v"(w.y), "+v"(acc[2][0]), "+v"(acc[2][1]), "+v"(acc[2][2]), "+v"(acc[2][3]), "+v"(acc[2][4]), "+v"(acc[2][5]), "+v"(acc[2][6]), "+v"(acc[2][7]),
                              "+v"(acc[3][0]), "+v"(acc[3][1]), "+v"(acc[3][2]), "+v"(acc[3][3]), "+v"(acc[3][4]), "+v"(acc[3][5]), "+v"(acc[3][6]), "+v"(acc[3][7]));
            f32x4 pn = pc; if (u + 1 < PU) pn = *(const LAS f32x4*)(pT + ((it0 + u + 1) * 4 + fq) * 4);
            float v[8]; unpack8_fp8(w, v);
#pragma unroll
            for (int hh = 0; hh < 4; ++hh)
#pragma unroll
                for (int d = 0; d < 8; ++d) acc[hh][d] = fmaf(pc[hh], v[d], acc[hh][d]);
            pc = pn;
        } };
    vload(r2, 2 * PU); vfma(r0, 0);
    vload(r0, 3 * PU); vfma(r1, PU);
    vload(r1, 4 * PU); vfma(r2, 2 * PU);
    vload(r2, 5 * PU); vfma(r0, 3 * PU);
    vload(r0, 6 * PU); vfma(r1, 4 * PU);
    vload(r1, 7 * PU); vfma(r2, 5 * PU);
    vfma(r0, 6 * PU); vfma(r1, 7 * PU);
#pragma unroll
    for (int hh = 0; hh < 4; ++hh)
#pragma unroll
        for (int d = 0; d < 8; ++d) { float a = acc[hh][d]; a += __shfl_xor(a, 16); a += __shfl_xor(a, 32); acc[hh][d] = a; }
    if (fq == 0) { bf16_t* op = X.W<bf16_t>(WS_OCAT) + (size_t)t * 4096 + 2048 + (4 * n) * 128 + fr * 8;
#pragma unroll
        for (int hh = 0; hh < 4; ++hh) *(u32x4*)(op + hh * 128) = pack8(acc[hh]); }
}
__device__ __forceinline__ void attn_samples(const Ctx& X) {
#pragma unroll 1
    for (int n0 = 0; n0 < 4; ++n0) {
        const int n = (X.bid + n0) & 3;
        unsigned* head = X.W<unsigned>(WS_CTL) + CW_IDXQ + 64 * (1 + n) + 32;
        for (;;) { unsigned k = 0; if (X.lane == 0) k = __hip_atomic_fetch_add(head, 1u, __ATOMIC_RELAXED, __HIP_MEMORY_SCOPE_AGENT);
            k = (unsigned)__builtin_amdgcn_readfirstlane((int)k);
            if (k >= (unsigned)(NTOK - SEQ)) break;
            attn_task_smp(X, SEQ + (int)k, n); }
    }
}
__device__ __forceinline__ void attn_prompts(const Ctx& X) {
    LAS int* lbuf = (LAS int*)(X.lds + X.wave * ATT_WLDS + 8192);
#pragma unroll 1
    for (int n0 = 0; n0 < 4; ++n0) {
        const int n = (X.bid + n0) & 3;
        unsigned* head = X.W<unsigned>(WS_CTL) + CW_IDXQ + 64 * (1 + n);
        auto pop = [&]() { unsigned k = 0; if (X.lane == 0) k = __hip_atomic_fetch_add(head, 1u, __ATOMIC_RELAXED, __HIP_MEMORY_SCOPE_AGENT); return k; };
        const unsigned k = (unsigned)__builtin_amdgcn_readfirstlane((int)pop());
        if (k >= (unsigned)SEQ) continue;
        AttnPre P; AttnCur C;
        attn_prefetch(X, (int)k, P);
        unsigned knv = pop();
        int b = 0;
        wave_sync();
        attn_stage(X, (int)k, n, P, lbuf, C);
#pragma unroll 1
        for (;;) {
            const unsigned kn = (unsigned)__builtin_amdgcn_readfirstlane((int)knv);
            const int tnext = kn < (unsigned)SEQ ? (int)kn : -1;
            if (tnext >= 0) { attn_prefetch(X, tnext, P); knv = pop(); }
            AttnCur Cn;
            attn_run8(X, n, C, lbuf + b * 256, tnext, P, lbuf + (b ^ 1) * 256, Cn);
            if (tnext < 0) break;
            C = Cn; b ^= 1;
        }
        wave_sync();
    }
}
__device__ __forceinline__ void late_weight_convert(const Ctx& X) {
    int lane = X.lane; asm volatile("" : "+v"(lane));
    LAS unsigned short* tile = (LAS unsigned short*)(X.lds + X.wave * SCAN_WLDS);
    const int kr = lane >> 4, nq = lane & 15;
    constexpr int T0 = 1024, T1 = 2048, T2 = 3072, T3 = 3072 + (DM / 64) * (UPN / 64), T4 = T3 + (DFF / 64) * (DM / 64);
    const int nslot = X.G * 8, slot0 = X.bid * 8 + X.wave;
#pragma unroll 1
    for (int ti = slot0; ti < T4; ti += nslot) {
        const float* src; bf16_t* dst; int N, ldd, loc;
        if (ti < T0) { src = X.in[I_WPA]; dst = X.W<bf16_t>(WS_WPA); N = DM; ldd = 4096; loc = ti; }
        else if (ti < T1) { src = X.in[I_WPB]; dst = X.W<bf16_t>(WS_WPA) + 2048; N = DM; ldd = 4096; loc = ti - T0; }
        else if (ti < T2) { src = X.in[I_WOUT]; dst = X.W<bf16_t>(WS_WOUT); N = DM; ldd = DM; loc = ti - T1; }
        else if (ti < T3) { src = X.in[I_WUP]; dst = X.W<bf16_t>(WS_WUP); N = UPN; ldd = DM; loc = ti - T2; }
        else { src = X.in[I_WDN]; dst = X.W<bf16_t>(WS_WDN); N = DM; ldd = DFF; loc = ti - T3; }
        const int nnt = N / 64, kt = loc / nnt, nt = loc - kt * nnt;
        f32x4 v[16];
        const float* sp = src + (size_t)(kt * 64 + kr) * N + nt * 64 + 4 * nq;
#pragma unroll
        for (int j = 0; j < 16; ++j) v[j] = __builtin_nontemporal_load((const f32x4*)(sp + (size_t)(4 * j) * N));
#pragma unroll
        for (int j = 0; j < 16; ++j) { u32x2 w; w.x = cvt_pk_bf16(v[j][0], v[j][1]); w.y = cvt_pk_bf16(v[j][2], v[j][3]); *(LAS u32x2*)(tile + (kr + 4 * j) * 68 + 4 * nq) = w; }
        wave_sync();
        const int ks = lane & 7, nr = lane >> 3;
        bf16_t* dp = dst + (size_t)(nt * 64 + nr) * ldd + kt * 64 + 8 * ks;
#pragma unroll
        for (int h = 0; h < 8; ++h) { unsigned short e[8];
#pragma unroll
            for (int j = 0; j < 8; ++j) e[j] = tile[(8 * ks + j) * 68 + 8 * h + nr];
            u32x4 w; w.x = e[0] | ((unsigned)e[1] << 16); w.y = e[2] | ((unsigned)e[3] << 16); w.z = e[4] | ((unsigned)e[5] << 16); w.w = e[6] | ((unsigned)e[7] << 16);
            __builtin_nontemporal_store(w, (u32x4*)(dp + (size_t)(8 * h) * ldd)); }
        wave_sync();
    }
}
__device__ __forceinline__ void phase_c_attn(const Ctx& X) {
    const bool hb = X.wave >= 4;
#pragma unroll 1
    for (int stage = 0; stage < 4; ++stage) {
        const int what = hb ? (stage == 0 ? 2 : stage == 1 ? 3 : stage - 2) : (stage == 0 ? 3 : stage - 1);
        if (what == 0) phase_scan_c(X);
        else if (what == 1) attn_prompts(X);
        else if (what == 2) attn_samples(X);
        else if (what == 3) late_weight_convert(X);
    }
}

__device__ __forceinline__ void phase_conv_act(const Ctx& X) {
    const bf16_t* U = X.W<bf16_t>(WS_U); bf16_t* ACT = X.W<bf16_t>(WS_ACT);
    const float* cw = X.in[I_CW]; const float* cb = X.in[I_CB];
    constexpr int PER = DFF / 8, NIT = NTOK * PER;
    struct Raw { float u0[8], uv[8], m1[8], m2[8]; };
    auto ld = [&](int item, Raw& R) {
        const int t = item / PER, f8 = (item - t * PER) * 8;
        const bool smp = t >= SEQ; const int tt = smp ? t - SEQ : t; const int p = smp ? (tt & 7) : t; const int b = tt >> 3;
        const bf16_t* ur = U + (size_t)t * UPN;
        unpack8(*(const u32x4*)(ur + f8), R.u0); unpack8(*(const u32x4*)(ur + DFF + f8), R.uv);
        const float* cprev = X.in[I_SCV] + (size_t)b * 2 * DFF;
        if (p >= 1) unpack8(*(const u32x4*)(ur - UPN + f8), R.m1);
        else {
#pragma unroll
            for (int j = 0; j < 8; ++j) R.m1[j] = smp ? cprev[DFF + f8 + j] : 0.f; }
        if (p >= 2) unpack8(*(const u32x4*)(ur - 2 * UPN + f8), R.m2);
        else {
#pragma unroll
            for (int j = 0; j < 8; ++j) R.m2[j] = smp ? cprev[p * DFF + f8 + j] : 0.f; } };
    auto fin = [&](int item, const Raw& R) {
        const int t = item / PER, f8 = (item - t * PER) * 8;
        const bool smp = t >= SEQ; const int tt = smp ? t - SEQ : t; const int p = smp ? (tt & 7) : t; const int b = tt >> 3;
        float o[8];
#pragma unroll
        for (int j = 0; j < 8; ++j) { const float a = cb[f8 + j] + cw[f8 + j] * R.m2[j] + cw[DFF + f8 + j] * R.m1[j] + cw[2 * DFF + f8 + j] * R.u0[j];
            o[j] = a * sigmoidf_(a) * R.uv[j]; }
        *(u32x4*)(ACT + (size_t)t * DFF + f8) = pack8(o);
        float* co = nullptr;
        if (!smp && t >= SEQ - 2) co = X.out + O_CVP + (size_t)(t - (SEQ - 2)) * DFF + f8;
        if (smp && p >= 6) co = X.out + O_CVS + ((size_t)b * 2 + (p - 6)) * DFF + f8;
        if (co) { *(f32x4*)co = (f32x4){R.u0[0], R.u0[1], R.u0[2], R.u0[3]}; *(f32x4*)(co + 4) = (f32x4){R.u0[4], R.u0[5], R.u0[6], R.u0[7]}; } };
    const int stride = X.G * 512;
    for (int item = X.bid * 512 + X.tid; item < NIT; item += 2 * stride) {
        Raw ra, rb; const bool two = item + stride < NIT;
        ld(item, ra); if (two) ld(item + stride, rb);
        fin(item, ra); if (two) fin(item + stride, rb);
    }
}

enum { PH_CONVERT = 0, PH_ADA, PH_NORM1, PH_GEMM1, PH_PREP1, PH_LORA, PH_PREP2, PH_SCAN_A, PH_SCAN_B, PH_SCAN_C, PH_INDEX, PH_ATTN, PH_PROJ, PH_OUT, PH_NORM2, PH_UP, PH_CONVACT, PH_DOWN, NPH };
#ifndef MK_N_LAUNCHES
#define MK_N_LAUNCHES 1
#endif
constexpr int CW_BAR = 1024;
#ifndef USE_TAILS
#define USE_TAILS 0
#endif
constexpr int CW_TAIL = 8192;

template <class Epi, int S_PARTS>
__device__ __forceinline__ void gemm_with_tail(const Ctx& X, const pg8::Gemm g, const Epi& E, int gemm_id) {
    using namespace pg8;
    StaticOrder S; S.init(g.M, g.N, X.G, X.bid);
    const int R = S.nwg / X.G;
    const bool tails = USE_TAILS || gemm_id == 5;
    if (!tails || S.nwg == R * X.G) { S.split_tail(); gemm_phase<Epi, StaticOrder, true, true>(X.lds, g, S, E, X.wave); return; }
    S.limit = R * X.G;
    if (R > 0) gemm_phase<Epi, StaticOrder, true, true>(X.lds, g, S, E, X.wave);
    TailOrder T; T.init_tail(g.M, g.N, X.G, X.bid, S_PARTS, g.K / S_PARTS);
    Gemm gt = g; gt.K = g.K / S_PARTS;
    EpiTail<Epi> ET{E, X.W<float>(WS_SLAB), X.W<unsigned>(WS_CTL) + CW_TAIL + gemm_id * 1024, S_PARTS};
    gemm_phase<EpiTail<Epi>, TailOrder, true, true>(X.lds, gt, T, ET, X.wave);
}

struct Args { const float* in[36]; float* out; unsigned char* ws; int ph_lo, ph_hi; };
__device__ __forceinline__ void fresh(Ctx& X) { KTab t = X.in; asm volatile("" : "+s"(t)); X.in = t; X.lane = lane_id_fresh(); X.tid = X.wave * 64 + X.lane; }

__global__ void __launch_bounds__(512, 2) mega(Args a) {
    extern __shared__ __attribute__((aligned(16))) unsigned char lds_raw[];
    Ctx X;
    X.in = (KTab)__builtin_amdgcn_kernarg_segment_ptr();
    X.out = a.out; X.ws = a.ws; X.lds = (LAS unsigned char*)lds_raw;
    X.wave = __builtin_amdgcn_readfirstlane((int)threadIdx.x >> 6); X.lane = lane_id_fresh(); X.tid = X.wave * 64 + X.lane; X.G = gridDim.x; X.bid = blockIdx.x;
    const int lo = a.ph_lo, hi = a.ph_hi;
    const bool multi = (hi - lo) > 1;
    volatile LAS unsigned* MISC = (volatile LAS unsigned*)(X.lds + LDS_MISC);
    if (X.tid < 4) MISC[X.tid] = 0u;
    __syncthreads();
    XcdBarrier bar; bar.bar = X.W<unsigned>(WS_CTL) + CW_BAR; bar.x = 0; bar.st = MISC;
    if (multi) bar = xcd_barrier_post(X.W<unsigned>(WS_CTL) + CW_BAR, MISC);
#ifndef PHASE_MASK
#define PHASE_MASK 0xFFFFFFFFu
#endif
#define IN(k) (((PHASE_MASK >> (k)) & 1u) && (fresh(X), lo <= (k) && (k) < hi))
#ifdef STAMP_BUILD
#define SEAM(k) do { if ((k) + 1 < hi) xcd_barrier(bar); if (X.bid == 0 && threadIdx.x == 0) X.W<unsigned long long>(WS_CTL)[16384 + (k) + 1] = wall_clock64(); } while (0)
#else
#define SEAM(k) do { if ((k) + 1 < hi) xcd_barrier(bar); } while (0)
#endif
    using namespace pg8;
    bf16_t* const Zb = X.W<bf16_t>(WS_Z); float* const MOD = X.W<float>(WS_MOD);

#ifdef STAMP_BUILD
    if (X.bid == 0 && threadIdx.x == 0) X.W<unsigned long long>(WS_CTL)[16384] = wall_clock64();
#endif
    if (IN(PH_CONVERT)) { phase_convert(X); SEAM(PH_CONVERT); }
    if (IN(PH_NORM1)) { phase_norm_mod(X, X.in[I_XP], X.in[I_XS], X.in[I_N1G], 0, 2048, X.W<bf16_t>(WS_H)); SEAM(PH_NORM1); }
    if (IN(PH_GEMM1)) {
        Gemm g{X.W<bf16_t>(WS_H), X.W<bf16_t>(WS_WIN), NTOK, ZLD, DM, DM, DM};
        EpiBf16<0> E{Zb, ZLD, nullptr};
        gemm_with_tail<EpiBf16<0>, 8>(X, g, E, 0);
        SEAM(PH_GEMM1);
    }
    if (IN(PH_PREP1)) { phase_prep1(X); SEAM(PH_PREP1); }
    if (IN(PH_LORA)) {
        StaticOrder S; S.init(NTOK, DM, X.G, X.bid);
        { Gemm g{X.W<bf16_t>(WS_ADEC), X.W<bf16_t>(WS_WDEC), NTOK, DM, 256, 256, 256}; EpiBf16<1> E{X.W<bf16_t>(WS_LW), DM, X.in[I_W0]};
          gemm_phase<EpiBf16<1>, StaticOrder, true, true>(X.lds, g, S, E, X.wave); }
        S.init(NTOK, DM, X.G, (X.bid + X.G - 32) % X.G);
        { Gemm g{X.W<bf16_t>(WS_AAIN), X.W<bf16_t>(WS_WA), NTOK, DM, 256, 256, 256}; EpiBf16<2> E{X.W<bf16_t>(WS_AAO), DM, X.in[I_A0]};
          gemm_phase<EpiBf16<2>, StaticOrder, true, true>(X.lds, g, S, E, X.wave); }
        S.init(NTOK, DM, X.G, (X.bid + X.G - 64) % X.G);
        { Gemm g{X.W<bf16_t>(WS_AGIN), X.W<bf16_t>(WS_WG), NTOK, DM, 256, 256, 256}; EpiBf16<0> E{X.W<bf16_t>(WS_GG), DM, nullptr};
          gemm_phase<EpiBf16<0>, StaticOrder, true, true>(X.lds, g, S, E, X.wave); }
        SEAM(PH_LORA);
    }
    if (IN(PH_PREP2)) { phase_prep2(X); }
    if (IN(PH_SCAN_A)) { phase_scan_a(X); SEAM(PH_SCAN_A); }
    if (IN(PH_SCAN_B)) { phase_scan_b(X); __syncthreads(); phase_index(X); SEAM(PH_SCAN_B); }
    if (IN(PH_SCAN_C)) { phase_c_attn(X); SEAM(PH_SCAN_C); }
#ifdef STAMP_BUILD
#define STAMPK(k) do { if (X.bid == 0 && threadIdx.x == 0) X.W<unsigned long long>(WS_CTL)[16384 + (k) + 1] = wall_clock64(); } while (0)
#else
#define STAMPK(k) do { } while (0)
#endif
    if (IN(PH_INDEX)) { STAMPK(PH_INDEX); }
    if (IN(PH_ATTN)) { STAMPK(PH_ATTN); }
    if (IN(PH_PROJ)) {
        { Gemm g{X.W<bf16_t>(WS_OCAT), X.W<bf16_t>(WS_WPA), NTOK, DM, DM, 4096, 4096}; EpiProjA E{X.W<bf16_t>(WS_TMPA), Zb};
          gemm_with_tail<EpiProjA, 8>(X, g, E, 1); }
#if USE_TAILS
        xcd_barrier(bar);
#endif
        { Gemm g{X.W<bf16_t>(WS_OCAT) + 2048, X.W<bf16_t>(WS_WPA) + 2048, NTOK, DM, DM, 4096, 4096}; EpiProjB E{X.W<bf16_t>(WS_TMPA), Zb, X.W<bf16_t>(WS_MIX)};
          gemm_with_tail<EpiProjB, 8>(X, g, E, 2); }
        SEAM(PH_PROJ);
    }
    if (IN(PH_OUT)) {
        Gemm g{X.W<bf16_t>(WS_MIX), X.W<bf16_t>(WS_WOUT), NTOK, DM, DM, DM, DM};
        EpiResidual E{X.in[I_XP], X.in[I_XS], MOD, 4096, X.W<float>(WS_XM)};
        gemm_with_tail<EpiResidual, 8>(X, g, E, 3);
        SEAM(PH_OUT);
    }
    if (IN(PH_NORM2)) { phase_norm_mod(X, X.W<float>(WS_XM), X.W<float>(WS_XM) + (size_t)SEQ * DM, X.in[I_N2G], 6144, 8192, X.W<bf16_t>(WS_H)); SEAM(PH_NORM2); }
    if (IN(PH_UP)) {
        Gemm g{X.W<bf16_t>(WS_H), X.W<bf16_t>(WS_WUP), NTOK, UPN, DM, DM, DM};
        EpiBf16<0> E{X.W<bf16_t>(WS_U), UPN, nullptr};
        gemm_with_tail<EpiBf16<0>, 8>(X, g, E, 4);
        SEAM(PH_UP);
    }
    if (IN(PH_CONVACT)) { phase_conv_act(X); SEAM(PH_CONVACT); }
    if (IN(PH_DOWN)) {
        Gemm g{X.W<bf16_t>(WS_ACT), X.W<bf16_t>(WS_WDN), NTOK, DM, DFF, DFF, DFF};
        EpiResidual E{X.W<float>(WS_XM), X.W<float>(WS_XM) + (size_t)SEQ * DM, MOD, 10240, X.out + O_YP};
        gemm_with_tail<EpiResidual, 4>(X, g, E, 5);
#ifdef STAMP_BUILD
        xcd_barrier(bar);
        if (X.bid == 0 && threadIdx.x == 0) {
            const unsigned long long* st = X.W<unsigned long long>(WS_CTL) + 16384; const unsigned long long tend = wall_clock64();
            auto us = [&](int a_, int b_) { return (int)(((b_ == NPH ? tend : st[b_]) - st[a_]) / 100ull); };
#if STAMP_BUILD == 4
            const unsigned long long* sw = st + 40;
            const int cnt[7] = { (int)(sw[0] / 100ull), (int)(sw[1] / 100ull), (int)(sw[4] / 100ull), (int)(sw[5] / 100ull), (int)(sw[6] / 100ull), 0, 0 };
#elif STAMP_BUILD == 3
            const unsigned long long* sw = st + 40;
            const int cnt[7] = { (int)(sw[0] / 100ull), (int)(sw[1] / 100ull), (int)(sw[2] / 100ull), (int)(sw[3] / 100ull), us(10, 11), 0, 0 };
#elif STAMP_BUILD == 1
            const int cnt[7] = { us(0, 1), us(3, 4), us(7, 8), us(8, 9), us(9, 10), us(10, 11), us(11, 12) };
#else
            const int cnt[7] = { us(1, 3), us(4, 5), us(5, 6), us(6, 7), us(12, 14), us(14, 16), us(16, NPH) };
#endif
            const size_t off[7] = { O_YP, O_RWS, O_KP, O_VP, O_YS, O_CVS, O_SHS };
            for (int o = 0; o < 7; ++o) for (int i = 0; i < cnt[o] / 4; ++i) ((unsigned*)X.out)[off[o] + i] = 0xAAAAAAAAu;
        }
#endif
    }
#undef IN
#undef SEAM
}

extern "C" void kernel_launch(void* const* d_in, const int* in_sizes, int n_in, void* d_out, int out_size, void* d_ws, size_t ws_size, hipStream_t stream) {
    static int grid = 0;
    if (grid == 0) {
        if (n_in != 36 || (size_t)out_size != O_END || ws_size < WS_END) { fprintf(stderr, "kernel_launch: unexpected shapes: n_in %d out %d ws %zu (need %zu)\n", n_in, out_size, ws_size, (size_t)WS_END); grid = -1; return; }
        int dev = 0, cus = 0, per_cu = 0;
        if (hipGetDevice(&dev) != hipSuccess || hipDeviceGetAttribute(&cus, hipDeviceAttributeMultiprocessorCount, dev) != hipSuccess) { grid = -1; return; }
        if (hipFuncSetAttribute((const void*)mega, hipFuncAttributeMaxDynamicSharedMemorySize, LDS_BYTES) != hipSuccess) { fprintf(stderr, "kernel_launch: hipFuncSetAttribute failed\n"); grid = -1; return; }
        if (hipOccupancyMaxActiveBlocksPerMultiprocessor(&per_cu, (const void*)mega, 512, LDS_BYTES) != hipSuccess || per_cu < 1) fprintf(stderr, "kernel_launch: occupancy query says %d\n", per_cu);
        (void)hipGetLastError();
        grid = cus;
    }
    if (grid < 0) return;
    (void)hipMemsetAsync((char*)d_ws + WS_CTL, 0, CTL_BYTES, stream);
    Args a{};
    for (int i = 0; i < 36; ++i) a.in[i] = (const float*)d_in[i];
    a.out = (float*)d_out; a.ws = (unsigned char*)d_ws;
    constexpr int NL = MK_N_LAUNCHES;
    for (int li = 0; li < NL; ++li) {
        a.ph_lo = (NL == 1) ? 0 : li; a.ph_hi = (NL == 1) ? NPH : li + 1;
        hipLaunchKernelGGL(mega, dim3(grid), dim3(512), LDS_BYTES, stream, a);
        const hipError_t le = hipPeekAtLastError();
        if (le != hipSuccess) { fprintf(stderr, "kernel_launch: launch %d failed: %s\n", li, hipGetErrorName(le)); break; }
    }
}
```

```cpp
#include <hip/hip_runtime.h>
#include <cstdio>
#include <cstdint>

#define LAS __attribute__((address_space(3)))
typedef unsigned short bf16_t;
typedef short bf16x8 __attribute__((ext_vector_type(8)));
typedef float f32x4 __attribute__((ext_vector_type(4)));
typedef float f32x16 __attribute__((ext_vector_type(16)));
typedef float f32x2 __attribute__((ext_vector_type(2)));
typedef unsigned u32x4 __attribute__((ext_vector_type(4)));
typedef unsigned u32x2 __attribute__((ext_vector_type(2)));

constexpr int DM = 2048, SEQ = 8192, DEC_B = 128, DEC_T = 8, NTOK = SEQ + DEC_B * DEC_T;
constexpr int SHIFT_W = 6592, IN_COLS = 14864, ZLD = 15104;
constexpr int C_R = 0, C_K = 2048, C_V = 4096, C_WD = 6144, C_AD = 6240, C_GD = 6336;
constexpr int C_Q = 6592, C_KK = 8640, C_VV = 9152, C_QI = 9664, C_KI = 10688, C_WI = 10752, C_GA = 10768, C_GB = 12816;
constexpr int DFF = 5632, UPN = 11264, MODLD = 12288;
constexpr int NPAGES = 16, PAGE = 128, PAST = 2048;
constexpr int CHUNK = 128, NCHUNK = SEQ / CHUNK;

constexpr size_t O_YP = 0, O_YS = O_YP + (size_t)SEQ * DM, O_KP = O_YS + (size_t)1024 * DM, O_VP = O_KP + (size_t)SEQ * 512, O_KIP = O_VP + (size_t)SEQ * 512,
                 O_RWP = O_KIP + (size_t)SEQ * 64, O_SHP = O_RWP + 32 * 64 * 64, O_CVP = O_SHP + SHIFT_W, O_KS = O_CVP + 2 * DFF, O_VS = O_KS + 1024 * 512,
                 O_KIS = O_VS + 1024 * 512, O_RWS = O_KIS + 1024 * 64, O_SHS = O_RWS + (size_t)DEC_B * 32 * 64 * 64, O_CVS = O_SHS + (size_t)DEC_B * SHIFT_W,
                 O_END = O_CVS + (size_t)DEC_B * 2 * DFF;
static_assert(O_END == 48113088, "output size");

constexpr size_t al256(size_t x) { return (x + 255) & ~(size_t)255; }
constexpr size_t WS_CTL = 0, CTL_BYTES = 1u << 20;
constexpr size_t WS_WIN = al256(WS_CTL + CTL_BYTES);
constexpr size_t WS_WADA = al256(WS_WIN + (size_t)ZLD * DM * 2);
constexpr size_t WS_WPA = al256(WS_WADA + (size_t)MODLD * DM * 2);
constexpr size_t WS_WOUT = al256(WS_WPA + (size_t)DM * 4096 * 2);
constexpr size_t WS_WUP = al256(WS_WOUT + (size_t)DM * DM * 2);
constexpr size_t WS_WDN = al256(WS_WUP + (size_t)UPN * DM * 2);
constexpr size_t WS_WDEC = al256(WS_WDN + (size_t)DM * DFF * 2);
constexpr size_t WS_WA = al256(WS_WDEC + (size_t)DM * 256 * 2);
constexpr size_t WS_WG = al256(WS_WA + (size_t)DM * 256 * 2);
constexpr size_t WS_ASILU = al256(WS_WG + (size_t)DM * 256 * 2);
constexpr size_t WS_MOD = al256(WS_ASILU + (size_t)256 * DM * 2);
constexpr size_t WS_H = al256(WS_MOD + (size_t)256 * MODLD * 4);
constexpr size_t WS_Z = al256(WS_H + (size_t)NTOK * DM * 2);
constexpr size_t WS_ADEC = al256(WS_Z + (size_t)NTOK * ZLD * 2);
constexpr size_t WS_AAIN = al256(WS_ADEC + (size_t)NTOK * 256 * 2);
constexpr size_t WS_AGIN = al256(WS_AAIN + (size_t)NTOK * 256 * 2);
constexpr size_t WS_LW = al256(WS_AGIN + (size_t)NTOK * 256 * 2);
constexpr size_t WS_AAO = al256(WS_LW + (size_t)NTOK * DM * 2);
constexpr size_t WS_GG = al256(WS_AAO + (size_t)NTOK * DM * 2);
constexpr size_t WS_RS = al256(WS_GG + (size_t)NTOK * DM * 2);
constexpr size_t WS_KS = al256(WS_RS + (size_t)NTOK * DM * 2);
constexpr size_t WS_VS = al256(WS_KS + (size_t)NTOK * DM * 2);
constexpr size_t WS_AS = al256(WS_VS + (size_t)NTOK * DM * 2);
constexpr size_t WS_BS = al256(WS_AS + (size_t)NTOK * DM * 2);
constexpr size_t WS_BON = al256(WS_BS + (size_t)NTOK * DM * 2);
constexpr size_t WS_PC = al256(WS_BON + (size_t)NTOK * 32 * 4);
constexpr size_t WS_UC = al256(WS_PC + (size_t)NCHUNK * 32 * 4096 * 4);
constexpr size_t WS_SC = al256(WS_UC + (size_t)NCHUNK * 32 * 4096 * 4);
constexpr size_t WS_OCAT = al256(WS_SC + (size_t)NCHUNK * 32 * 4096 * 4);
constexpr size_t WS_QB = al256(WS_OCAT + (size_t)NTOK * 4096 * 2);
constexpr size_t WS_KB = al256(WS_QB + (size_t)NTOK * DM * 2);
constexpr size_t WS_VB = al256(WS_KB + (size_t)NTOK * 512 * 2);
constexpr size_t WS_KIB = al256(WS_VB + (size_t)NTOK * 512 * 2);
constexpr size_t WS_WI = al256(WS_KIB + (size_t)NTOK * 64 * 2);
constexpr size_t WS_IDX = al256(WS_WI + (size_t)NTOK * 16 * 4);
constexpr size_t WS_NSEL = al256(WS_IDX + (size_t)NTOK * 256 * 4);
constexpr size_t WS_TMPA = al256(WS_NSEL + (size_t)NTOK * 4);
constexpr size_t WS_MIX = al256(WS_TMPA + (size_t)NTOK * DM * 4);
constexpr size_t WS_XM = al256(WS_MIX + (size_t)NTOK * DM * 2);
constexpr size_t WS_U = al256(WS_XM + (size_t)NTOK * DM * 4);
constexpr size_t WS_ACT = al256(WS_U + (size_t)NTOK * UPN * 2);
constexpr size_t WS_PB = al256(WS_ACT + (size_t)NTOK * DFF * 2);
constexpr size_t WS_QV = al256(WS_PB + (size_t)NTOK * 4 * 1024 * 2);
constexpr size_t WS_UR = al256(WS_QV + (size_t)SEQ * DM * 2);
constexpr size_t WS_Q8 = al256(WS_UR + (size_t)SEQ * DM * 2);
constexpr size_t WS_K8 = al256(WS_Q8 + (size_t)SEQ * DM);
constexpr size_t WS_V8 = al256(WS_K8 + (size_t)SEQ * 512);
constexpr size_t WS_SLAB = al256(WS_V8 + (size_t)SEQ * 512);
constexpr size_t WS_END = al256(WS_SLAB + (size_t)640 * 262144);

constexpr int LDS_BYTES = 155648;
constexpr int LDS_MISC = 147456;

typedef __bf16 bf16x2_t __attribute__((ext_vector_type(2)));
__device__ __forceinline__ unsigned cvt_pk_bf16(float lo, float hi) { f32x2 v = {lo, hi}; bf16x2_t b = __builtin_convertvector(v, bf16x2_t); return __builtin_bit_cast(unsigned, b); }
__device__ __forceinline__ float bf_lo(unsigned w) { return __uint_as_float(w << 16); }
__device__ __forceinline__ float bf_hi(unsigned w) { return __uint_as_float(w & 0xffff0000u); }
__device__ __forceinline__ float bf2f(bf16_t b) { return __uint_as_float(((unsigned)b) << 16); }
__device__ __forceinline__ bf16_t f2bf(float f) { return (bf16_t)(cvt_pk_bf16(f, 0.f) & 0xffffu); }
__device__ __forceinline__ void unpack8(const u32x4 w, float (&f)[8]) {
    f[0] = bf_lo(w.x); f[1] = bf_hi(w.x); f[2] = bf_lo(w.y); f[3] = bf_hi(w.y); f[4] = bf_lo(w.z); f[5] = bf_hi(w.z); f[6] = bf_lo(w.w); f[7] = bf_hi(w.w); }
__device__ __forceinline__ u32x4 pack8(const float (&f)[8]) { u32x4 w; w.x = cvt_pk_bf16(f[0], f[1]); w.y = cvt_pk_bf16(f[2], f[3]); w.z = cvt_pk_bf16(f[4], f[5]); w.w = cvt_pk_bf16(f[6], f[7]); return w; }
template <int CTRL> __device__ __forceinline__ float dpp_f(float x) { return __builtin_bit_cast(float, __builtin_amdgcn_update_dpp(0, __builtin_bit_cast(int, x), CTRL, 0xf, 0xf, true)); }
__device__ __forceinline__ float row16_sum(float x) {
    x += dpp_f<0xB1>(x); x += dpp_f<0x4E>(x); x += dpp_f<0x141>(x); x += dpp_f<0x140>(x); return x; }
__device__ __forceinline__ float row16_max(float x) {
    x = fmaxf(x, dpp_f<0xB1>(x)); x = fmaxf(x, dpp_f<0x4E>(x)); x = fmaxf(x, dpp_f<0x141>(x)); x = fmaxf(x, dpp_f<0x140>(x)); return x; }
__device__ __forceinline__ float row8_sum(float x) { x += dpp_f<0xB1>(x); x += dpp_f<0x4E>(x); x += dpp_f<0x141>(x); return x; }
__device__ __forceinline__ float wave_sum(float x) {
    x = row16_sum(x);
    const float a = __builtin_bit_cast(float, __builtin_amdgcn_readlane(__builtin_bit_cast(int, x), 0)), b = __builtin_bit_cast(float, __builtin_amdgcn_readlane(__builtin_bit_cast(int, x), 16)),
                c = __builtin_bit_cast(float, __builtin_amdgcn_readlane(__builtin_bit_cast(int, x), 32)), d = __builtin_bit_cast(float, __builtin_amdgcn_readlane(__builtin_bit_cast(int, x), 48));
    return (a + b) + (c + d); }
__device__ __forceinline__ float rows4_sum(float x) {
    typedef unsigned u2_t __attribute__((ext_vector_type(2)));
    u2_t r = __builtin_amdgcn_permlane16_swap(__builtin_bit_cast(unsigned, x), __builtin_bit_cast(unsigned, x), false, false);
    const float t = __builtin_bit_cast(float, r.x) + __builtin_bit_cast(float, r.y);
    u2_t q = __builtin_amdgcn_permlane32_swap(__builtin_bit_cast(unsigned, t), __builtin_bit_cast(unsigned, t), false, false);
    return __builtin_bit_cast(float, q.x) + __builtin_bit_cast(float, q.y); }
__device__ __forceinline__ float sigmoidf_(float x) { return __builtin_amdgcn_rcpf(1.f + __expf(-x)); }
__device__ __forceinline__ int lane_id_fresh() { int l; asm volatile("v_mbcnt_lo_u32_b32 %0, -1, 0\n\tv_mbcnt_hi_u32_b32 %0, -1, %0" : "=v"(l)); return l; }
__device__ __forceinline__ u32x2 pack8_fp8(const float (&f)[8]) { int a = 0, b = 0;
    a = __builtin_amdgcn_cvt_pk_fp8_f32(f[0], f[1], a, false); a = __builtin_amdgcn_cvt_pk_fp8_f32(f[2], f[3], a, true);
    b = __builtin_amdgcn_cvt_pk_fp8_f32(f[4], f[5], b, false); b = __builtin_amdgcn_cvt_pk_fp8_f32(f[6], f[7], b, true);
    u32x2 r; r.x = (unsigned)a; r.y = (unsigned)b; return r; }
__device__ __forceinline__ void unpack8_fp8(const u32x2 w, float (&f)[8]) {
    const f32x2 a = __builtin_amdgcn_cvt_pk_f32_fp8((int)w.x, false), b = __builtin_amdgcn_cvt_pk_f32_fp8((int)w.x, true), c = __builtin_amdgcn_cvt_pk_f32_fp8((int)w.y, false), d = __builtin_amdgcn_cvt_pk_f32_fp8((int)w.y, true);
    f[0] = a[0]; f[1] = a[1]; f[2] = b[0]; f[3] = b[1]; f[4] = c[0]; f[5] = c[1]; f[6] = d[0]; f[7] = d[1]; }
__device__ __forceinline__ void wave_sync() { asm volatile("s_waitcnt lgkmcnt(0)" ::: "memory"); __builtin_amdgcn_wave_barrier(); asm volatile("" ::: "memory"); }

namespace pg8 {
#define PG8_LAS __attribute__((address_space(3)))
constexpr int BM = 256, BK = 64, HALF = 128, HTB = HALF * BK * 2  , STAGE_BYTES = 8 * HTB, NXCD = 8, WGM = 8;

__host__ __device__ __forceinline__ int lds_byte(int r, int c) { const int st = (r >> 4) * 2 + (c >> 5), rr = r & 15, cc = c & 31, ob = rr * 64 + cc * 2; return st * 1024 + (ob ^ (((ob >> 9) & 1) << 5)); }
__host__ __device__ __forceinline__ void stage_rc(int b, int& R, int& C) { const int st = b / 1024, sb = b % 1024, swz = sb ^ (((sb >> 9) & 1) << 5); R = (st >> 1) * 16 + swz / 64; C = (st & 1) * 32 + (swz % 64) / 2; }
__host__ __device__ __forceinline__ int perm32(int rho) { const int n = rho >> 4, i = rho & 15; return 8 * (i >> 2) + 4 * n + (i & 3); }

struct Unit { int pm, pn, kofs, q, p, nh; };
struct Gemm { const bf16_t* A; const bf16_t* Bt; int M, N, K, lda, ldb; };

struct StaticOrder {
    int nM, nN, nwg, G, c, limit, halves;
    __host__ __device__ void init(int M, int N, int G_, int c_) { nM = M / BM; nN = N / BM; nwg = nM * nN; G = G_; c = c_; limit = nwg; halves = 0; }
    __host__ __device__ void split_tail() { if (nwg % G) { limit = (nwg / G) * G; halves = 1; } }
    __host__ __device__ void tile_of(int L, Unit& u) const {
        int wgid = L; { const int q = nwg / NXCD, r = nwg % NXCD, xcd = wgid % NXCD, off = wgid / NXCD; wgid = (xcd < r ? xcd * (q + 1) : r * (q + 1) + (xcd - r) * q) + off; }
        const int nig = WGM * nN, gid = wgid / nig, fm = gid * WGM, gsz = (nM - fm) < WGM ? (nM - fm) : WGM;
        u.pm = fm + ((wgid % nig) % gsz); u.pn = (wgid % nig) / gsz; }
    __host__ __device__ bool next(int i, Unit& u) const {
        const long L = (long)i * G + c; u.kofs = 0; u.q = 0; u.p = 0; u.nh = -1;
        if (L < limit) { tile_of((int)L, u); return true; }
        if (!halves) return false;
        const long t = L - limit; if (t >= 2L * (nwg - limit)) return false;
        tile_of(limit + (int)(t >> 1), u); u.nh = (int)(t & 1); return true;
    }
    __device__ __forceinline__ void a_ready(const Unit&) const {}
    __device__ __forceinline__ void done(const Unit&) const {}
};
struct TailOrder : StaticOrder {
    int base, s, kpart;
    __host__ __device__ void init_tail(int M, int N, int G_, int c_, int s_, int kpart_) { init(M, N, G_, c_); base = (nwg / G) * G; s = s_; kpart = kpart_; }
    __host__ __device__ bool next(int i, Unit& u) const {
        const int j = i * G + c; if (j >= (nwg - base) * s) return false;
        u.q = j / s; u.p = j - u.q * s; tile_of(base + u.q, u); u.kofs = u.p * kpart; u.nh = -1; return true;
    }
};


typedef f32x4 AccT[2][2][4][2];
__device__ __forceinline__ int mod_row(int r) { return r < SEQ ? 0 : 1 + ((r - SEQ) >> 3); }

struct EpiF32Bias {
    static constexpr bool PERM = false, AFTER_DRAIN = false;
    float* C; int ldc; const float* bias;
    __device__ __forceinline__ void operator()(const AccT& acc, const Unit& u, int wr, int wc, int fr, int fq) const {
        const int row0 = u.pm * BM + wr * 64 + fr, col0 = u.pn * BM + wc * 32 + 4 * fq;
        f32x4 bv[2][2];
#pragma unroll
        for (int bj = 0; bj < 2; ++bj)
#pragma unroll
            for (int n = 0; n < 2; ++n) bv[bj][n] = *(const f32x4*)(bias + col0 + bj * HALF + n * 16);
#pragma unroll
        for (int ai = 0; ai < 2; ++ai)
#pragma unroll
            for (int m = 0; m < 4; ++m) { float* rowp = C + (size_t)(row0 + ai * HALF + m * 16) * ldc + col0;
#pragma unroll
                for (int bj = 0; bj < 2; ++bj)
#pragma unroll
                    for (int n = 0; n < 2; ++n) *(f32x4*)(rowp + bj * HALF + n * 16) = acc[ai][bj][m][n] + bv[bj][n]; }
    }
};
template <int MODE> struct EpiBf16 {
    static constexpr bool PERM = true, AFTER_DRAIN = false;
    bf16_t* O; int ldc; const float* p;
    __device__ __forceinline__ void operator()(const AccT& acc, const Unit& u, int wr, int wc, int fr, int fq) const {
        const int row0 = u.pm * BM + wr * 64 + fr, col0 = u.pn * BM + wc * 32 + 8 * fq;
#pragma unroll
        for (int bj = 0; bj < 2; ++bj) { if (u.nh >= 0 && bj != u.nh) continue;
            f32x4 pv0 = {0.f, 0.f, 0.f, 0.f}, pv1 = pv0;
            if (MODE) { pv0 = *(const f32x4*)(p + col0 + bj * HALF); pv1 = *(const f32x4*)(p + col0 + bj * HALF + 4); }
#pragma unroll
            for (int ai = 0; ai < 2; ++ai)
#pragma unroll
                for (int m = 0; m < 4; ++m) { bf16_t* rowp = O + (size_t)(row0 + ai * HALF + m * 16) * ldc + col0;
                    f32x4 v0 = acc[ai][bj][m][0] + pv0, v1 = acc[ai][bj][m][1] + pv1;
                    if (MODE == 1 || MODE == 2) {
                        const float sc = (MODE == 1) ? -0.60653065971f : 1.f;
#pragma unroll
                        for (int e = 0; e < 4; ++e) { v0[e] = sc * sigmoidf_(v0[e]); v1[e] = sc * sigmoidf_(v1[e]); }
                    }
                    u32x4 w; w.x = cvt_pk_bf16(v0[0], v0[1]); w.y = cvt_pk_bf16(v0[2], v0[3]); w.z = cvt_pk_bf16(v1[0], v1[1]); w.w = cvt_pk_bf16(v1[2], v1[3]);
                    *(u32x4*)(rowp + bj * HALF) = w; }
        }
    }
};
struct EpiProjA {
    static constexpr bool PERM = false, AFTER_DRAIN = false;
    bf16_t* T; const bf16_t* Z;
    __device__ __forceinline__ void operator()(const AccT& acc, const Unit& u, int wr, int wc, int fr, int fq) const {
        const int row0 = u.pm * BM + wr * 64 + fr, col0 = u.pn * BM + wc * 32 + 4 * fq;
#pragma unroll
        for (int ai = 0; ai < 2; ++ai)
#pragma unroll
            for (int m = 0; m < 4; ++m) { const int r = row0 + ai * HALF + m * 16; bf16_t* rowp = T + (size_t)r * DM + col0; const bf16_t* zp = Z + (size_t)r * ZLD + C_GA + col0;
#pragma unroll
                for (int bj = 0; bj < 2; ++bj) if (u.nh < 0 || bj == u.nh)
#pragma unroll
                    for (int n = 0; n < 2; ++n) { const u32x2 gz = *(const u32x2*)(zp + bj * HALF + n * 16); f32x4 a = acc[ai][bj][m][n];
                        a[0] *= sigmoidf_(bf_lo(gz.x)); a[1] *= sigmoidf_(bf_hi(gz.x)); a[2] *= sigmoidf_(bf_lo(gz.y)); a[3] *= sigmoidf_(bf_hi(gz.y));
                        u32x2 w; w.x = cvt_pk_bf16(a[0], a[1]); w.y = cvt_pk_bf16(a[2], a[3]); *(u32x2*)(rowp + bj * HALF + n * 16) = w; } }
    }
};
struct EpiProjB {
    static constexpr bool PERM = true, AFTER_DRAIN = false;
    const bf16_t* T; const bf16_t* Z; bf16_t* O;
    __device__ __forceinline__ void operator()(const AccT& acc, const Unit& u, int wr, int wc, int fr, int fq) const {
        const int row0 = u.pm * BM + wr * 64 + fr, col0 = u.pn * BM + wc * 32 + 8 * fq;
#pragma unroll
        for (int ai = 0; ai < 2; ++ai)
#pragma unroll
            for (int m = 0; m < 4; ++m) { const int r = row0 + ai * HALF + m * 16; const bf16_t* tp = T + (size_t)r * DM + col0; const bf16_t* zp = Z + (size_t)r * ZLD + C_GB + col0; bf16_t* op = O + (size_t)r * DM + col0;
#pragma unroll
                for (int bj = 0; bj < 2; ++bj) { if (u.nh >= 0 && bj != u.nh) continue; const u32x4 gz = *(const u32x4*)(zp + bj * HALF); const u32x4 tw = *(const u32x4*)(tp + bj * HALF); const f32x4 t0 = {bf_lo(tw.x), bf_hi(tw.x), bf_lo(tw.y), bf_hi(tw.y)}, t1 = {bf_lo(tw.z), bf_hi(tw.z), bf_lo(tw.w), bf_hi(tw.w)};
                    const f32x4 a0 = acc[ai][bj][m][0], a1 = acc[ai][bj][m][1]; float o[8];
                    o[0] = t0[0] + sigmoidf_(bf_lo(gz.x)) * a0[0]; o[1] = t0[1] + sigmoidf_(bf_hi(gz.x)) * a0[1]; o[2] = t0[2] + sigmoidf_(bf_lo(gz.y)) * a0[2]; o[3] = t0[3] + sigmoidf_(bf_hi(gz.y)) * a0[3];
                    o[4] = t1[0] + sigmoidf_(bf_lo(gz.z)) * a1[0]; o[5] = t1[1] + sigmoidf_(bf_hi(gz.z)) * a1[1]; o[6] = t1[2] + sigmoidf_(bf_lo(gz.w)) * a1[2]; o[7] = t1[3] + sigmoidf_(bf_hi(gz.w)) * a1[3];
                    *(u32x4*)(op + bj * HALF) = pack8(o); } }
    }
};
struct EpiResidual {
    static constexpr bool PERM = false, AFTER_DRAIN = false;
    const float* res_p; const float* res_s; const float* MOD; int goff; float* OUT;
    __device__ __forceinline__ void operator()(const AccT& acc, const Unit& u, int wr, int wc, int fr, int fq) const {
        const int row0 = u.pm * BM + wr * 64 + fr, col0 = u.pn * BM + wc * 32 + 4 * fq;
#pragma unroll
        for (int ai = 0; ai < 2; ++ai)
#pragma unroll
            for (int m = 0; m < 4; ++m) { const int r = row0 + ai * HALF + m * 16;
                const float* rp = (r < SEQ ? res_p + (size_t)r * DM : res_s + (size_t)(r - SEQ) * DM) + col0;
                const float* gp = MOD + (size_t)mod_row(r) * MODLD + goff + col0; float* op = OUT + (size_t)r * DM + col0;
#pragma unroll
                for (int bj = 0; bj < 2; ++bj) if (u.nh < 0 || bj == u.nh)
#pragma unroll
                    for (int n = 0; n < 2; ++n) { const f32x4 x = *(const f32x4*)(rp + bj * HALF + n * 16), g = *(const f32x4*)(gp + bj * HALF + n * 16);
                        *(f32x4*)(op + bj * HALF + n * 16) = x + g * acc[ai][bj][m][n]; }
                asm volatile("" ::: "memory"); }
    }
};

template <class Epi> struct EpiTail {
    static constexpr bool PERM = Epi::PERM, AFTER_DRAIN = false;
    Epi E; float* slabs; unsigned* cnt; int s;
    __device__ __forceinline__ void operator()(const AccT& acc, const Unit& u, int wr, int wc, int fr, int fq) const {
        const int wave = wr * 4 + wc, tid = wave * 64 + fq * 16 + fr;
        const __amdgpu_buffer_rsrc_t rs = __builtin_amdgcn_make_buffer_rsrc((void*)(slabs + (size_t)u.q * s * 65536), 0, s * 262144, 0x00020000);
        const unsigned off0 = (unsigned)u.p * 262144u + (unsigned)tid * 16u;
#pragma unroll
        for (int ai = 0; ai < 2; ++ai)
#pragma unroll
            for (int bj = 0; bj < 2; ++bj)
#pragma unroll
                for (int m = 0; m < 4; ++m)
#pragma unroll
                    for (int n = 0; n < 2; ++n) { const int k = ((ai * 2 + bj) * 4 + m) * 2 + n;
                        __builtin_amdgcn_raw_buffer_store_b128(__builtin_bit_cast(u32x4, acc[ai][bj][m][n]), rs, off0 + (unsigned)k * 8192u, 0, 16); }
        asm volatile("s_waitcnt vmcnt(0)" ::: "memory");
        unsigned old = 0;
        if (fq == 0 && fr == 0) old = __hip_atomic_fetch_add(cnt + u.q * 8 + wave, 1u, __ATOMIC_RELAXED, __HIP_MEMORY_SCOPE_AGENT);
        old = (unsigned)__builtin_amdgcn_readfirstlane((int)old);
        if (old == (unsigned)(s - 1)) {
            __builtin_amdgcn_fence(__ATOMIC_ACQUIRE, "agent");
            asm volatile("s_waitcnt vmcnt(0)" ::: "memory");
            AccT sum;
#pragma unroll
            for (int ai = 0; ai < 2; ++ai) {
#pragma unroll
                for (int bj = 0; bj < 2; ++bj)
#pragma unroll
                    for (int m = 0; m < 4; ++m)
#pragma unroll
                        for (int n = 0; n < 2; ++n) sum[ai][bj][m][n] = (f32x4){0.f, 0.f, 0.f, 0.f};
#pragma unroll 1
                for (int pp = 0; pp < s; ++pp) {
                    const unsigned po = (unsigned)pp * 262144u + (unsigned)tid * 16u + (unsigned)ai * 16u * 8192u;
#pragma unroll
                    for (int bj = 0; bj < 2; ++bj)
#pragma unroll
                        for (int m = 0; m < 4; ++m)
#pragma unroll
                            for (int n = 0; n < 2; ++n) { const int k = (bj * 4 + m) * 2 + n;
                                sum[ai][bj][m][n] += __builtin_bit_cast(f32x4, __builtin_amdgcn_raw_buffer_load_b128(rs, po + (unsigned)k * 8192u, 0, 16)); }
                }
            }
            E(sum, u, wr, wc, fr, fq);
        }
    }
};
template <class Epi, class Sched, bool ALIGN_EPI = false, bool SP2 = false>
__device__ __forceinline__ void gemm_phase(PG8_LAS unsigned char* lds, const Gemm g, const Sched& S, const Epi& E, const int wid  ) {
    const int lane = lane_id_fresh(), tid = wid * 64 + lane, wr = wid >> 2, wc = wid & 3, fr = lane & 15, fq = lane >> 4;
    const int K = g.K, nt = K / BK;
    unsigned voffA[2], voffB[2];
#pragma unroll
    for (int i = 0; i < 2; ++i) { int R, C; stage_rc(tid * 16 + i * 8192, R, C); const int Rb = Epi::PERM ? ((R & ~31) + perm32(R & 31)) : R;
        voffA[i] = (unsigned)(R * g.lda + C) * 2u; voffB[i] = (unsigned)(Rb * g.ldb + C) * 2u; }
    const size_t kstep = (size_t)(BK * 2);
    const size_t hstepA = (size_t)HALF * g.lda * 2, hstepB = (size_t)HALF * g.ldb * 2;
    const size_t tstepA = 2 * hstepA, tstepB = 2 * hstepB;
    const unsigned ldsw = (unsigned)wid * 1024u;
    const int aoff = lds_byte(wr * 64 + fr, fq * 8), boff = lds_byte(wc * 32 + fr, fq * 8);
#define PG8_SA(b, h) (((b) * 2 + (h)) * HTB)
#define PG8_SB(b, h) ((4 + (b) * 2 + (h)) * HTB)
#define PG8_STAGE(bufoff, gbase, voff) do { _Pragma("unroll") for (int _i = 0; _i < 2; ++_i) \
        __builtin_amdgcn_global_load_lds((const unsigned*)((const char*)(gbase) + (voff)[_i]), (PG8_LAS unsigned*)(lds + (bufoff) + ldsw + _i * 8192), 16, 0, 0); } while (0)
#define PG8_LDA(dst, b, h) do { _Pragma("unroll") for (int m = 0; m < 4; ++m) _Pragma("unroll") for (int k = 0; k < 2; ++k) dst[m][k] = *(const PG8_LAS bf16x8*)(lds + PG8_SA(b, h) + aoff + m * 2048 + k * 1024); } while (0)
#define PG8_LDB(dst, b, h) do { _Pragma("unroll") for (int n = 0; n < 2; ++n) _Pragma("unroll") for (int k = 0; k < 2; ++k) dst[n][k] = *(const PG8_LAS bf16x8*)(lds + PG8_SB(b, h) + boff + n * 2048 + k * 1024); } while (0)
#define PG8_MMA(ai, bj, At, Bt) do { __builtin_amdgcn_s_setprio(1); _Pragma("unroll") for (int m = 0; m < 4; ++m) _Pragma("unroll") for (int n = 0; n < 2; ++n) _Pragma("unroll") for (int k = 0; k < 2; ++k) \
        acc[ai][bj][m][n] = __builtin_amdgcn_mfma_f32_16x16x32_bf16(Bt[n][k], At[m][k], acc[ai][bj][m][n], 0, 0, 0); __builtin_amdgcn_s_setprio(0); } while (0)
#define PG8_WAIT_V(n) asm volatile("s_waitcnt vmcnt(" #n ")" ::: "memory")
#define PG8_WAIT_L(n) asm volatile("s_waitcnt lgkmcnt(" #n ")" ::: "memory")
#define PG8_BAR __builtin_amdgcn_s_barrier()
#define PG8_SCHED __builtin_amdgcn_sched_barrier(0)
#define PG8_KLOOP(G1, G0) _Pragma("unroll 1") \
        for (int t = 0; t < nt; t += 2) { \
            const bool last = (t == nt - 2); \
            const char* a1 = cA + (size_t)(t + 1) * kstep; \
            const char* a2 = last ? nA : cA + (size_t)(t + 2) * kstep; const char* b2 = last ? nB : cB + (size_t)(t + 2) * kstep; \
            const char* a3 = a2 + kstep; const char* b3 = b2 + kstep; \
            if (last && has_next) S.a_ready(nxt); \
            if constexpr (SP2) { \
            PG8_LDB(B0, 0, 0); PG8_LDB(B1, 0, 1); PG8_SCHED; PG8_LDA(At, 0, 0); PG8_STAGE(PG8_SA(1, 1), a1 + hstepA, voffA); \
            PG8_WAIT_V(8); PG8_WAIT_L(0); PG8_BAR; if (G1) PG8_MMA(0, 0, At, B0); if (G0) PG8_MMA(0, 1, At, B1); PG8_BAR; PG8_SCHED; \
            PG8_LDA(At, 0, 1); PG8_STAGE(PG8_SB(0, 0), b2, voffB); PG8_STAGE(PG8_SB(0, 1), b2 + hstepB, voffB); PG8_STAGE(PG8_SA(0, 0), a2, voffA); \
            PG8_WAIT_V(8); PG8_WAIT_L(0); PG8_BAR; if (G1) PG8_MMA(1, 0, At, B0); if (G0) PG8_MMA(1, 1, At, B1); PG8_BAR; PG8_SCHED; \
            PG8_LDB(B0, 1, 0); PG8_LDB(B1, 1, 1); PG8_SCHED; PG8_LDA(At, 1, 0); PG8_STAGE(PG8_SA(0, 1), a2 + hstepA, voffA); \
            PG8_WAIT_V(8); PG8_WAIT_L(0); PG8_BAR; if (G1) PG8_MMA(0, 0, At, B0); if (G0) PG8_MMA(0, 1, At, B1); PG8_BAR; PG8_SCHED; \
            PG8_LDA(At, 1, 1); PG8_STAGE(PG8_SB(1, 0), b3, voffB); PG8_STAGE(PG8_SB(1, 1), b3 + hstepB, voffB); PG8_STAGE(PG8_SA(1, 0), a3, voffA); \
            PG8_WAIT_V(8); PG8_WAIT_L(0); PG8_BAR; if (G1) PG8_MMA(1, 0, At, B0); if (G0) PG8_MMA(1, 1, At, B1); PG8_BAR; PG8_SCHED; \
            } else { \
            PG8_LDB(B0, 0, 0); PG8_SCHED; PG8_LDA(At, 0, 0); PG8_STAGE(PG8_SA(1, 1), a1 + hstepA, voffA); \
            PG8_WAIT_L(8); PG8_BAR; PG8_WAIT_L(0); PG8_MMA(0, 0, At, B0); PG8_BAR; PG8_SCHED; \
            PG8_LDB(B1, 0, 1); PG8_STAGE(PG8_SB(0, 0), b2, voffB); \
            PG8_BAR; PG8_WAIT_L(0); PG8_MMA(0, 1, At, B1); PG8_BAR; \
            PG8_LDA(At, 0, 1); PG8_STAGE(PG8_SA(0, 0), a2, voffA); \
            PG8_BAR; PG8_WAIT_L(0); PG8_MMA(1, 0, At, B0); PG8_BAR; PG8_SCHED; \
            PG8_STAGE(PG8_SB(0, 1), b2 + hstepB, voffB); \
            PG8_WAIT_V(6); PG8_BAR; PG8_MMA(1, 1, At, B1); PG8_BAR; \
            PG8_LDB(B0, 1, 0); PG8_SCHED; PG8_LDA(At, 1, 0); PG8_STAGE(PG8_SA(0, 1), a2 + hstepA, voffA); \
            PG8_WAIT_L(8); PG8_BAR; PG8_WAIT_L(0); PG8_MMA(0, 0, At, B0); PG8_BAR; PG8_SCHED; \
            PG8_LDB(B1, 1, 1); PG8_STAGE(PG8_SB(1, 0), b3, voffB); \
            PG8_BAR; PG8_WAIT_L(0); PG8_MMA(0, 1, At, B1); PG8_BAR; \
            PG8_LDA(At, 1, 1); PG8_STAGE(PG8_SA(1, 0), a3, voffA); \
            PG8_BAR; PG8_WAIT_L(0); PG8_MMA(1, 0, At, B0); PG8_BAR; PG8_SCHED; \
            PG8_STAGE(PG8_SB(1, 1), b3 + hstepB, voffB); \
            PG8_WAIT_V(6); PG8_BAR; PG8_MMA(1, 1, At, B1); PG8_BAR; \
            } \
        }
    Unit cur, nxt; int ui = 0;
    if (!S.next(0, cur)) return;
    f32x4 acc[2][2][4][2];
#pragma unroll
    for (int a = 0; a < 2; ++a)
#pragma unroll
        for (int b = 0; b < 2; ++b)
#pragma unroll
            for (int m = 0; m < 4; ++m)
#pragma unroll
                for (int n = 0; n < 2; ++n) acc[a][b][m][n] = (f32x4){0.f, 0.f, 0.f, 0.f};
    bf16x8 At[4][2], B0[2][2], B1[2][2];
    const char* cA = (const char*)g.A + (size_t)cur.pm * tstepA + (size_t)cur.kofs * 2; const char* cB = (const char*)g.Bt + (size_t)cur.pn * tstepB + (size_t)cur.kofs * 2;
    S.a_ready(cur);
    if constexpr (SP2) {
        PG8_STAGE(PG8_SB(0, 0), cB, voffB); PG8_STAGE(PG8_SB(0, 1), cB + hstepB, voffB); PG8_STAGE(PG8_SA(0, 0), cA, voffA); PG8_STAGE(PG8_SA(0, 1), cA + hstepA, voffA);
        if (wr == 1) PG8_BAR;
        PG8_WAIT_V(2); PG8_BAR;
        PG8_STAGE(PG8_SB(1, 0), cB + kstep, voffB); PG8_STAGE(PG8_SA(1, 0), cA + kstep, voffA); PG8_STAGE(PG8_SB(1, 1), cB + hstepB + kstep, voffB);
        PG8_WAIT_V(6); PG8_BAR;
    } else {
        PG8_STAGE(PG8_SB(0, 0), cB, voffB); PG8_STAGE(PG8_SA(0, 0), cA, voffA); PG8_STAGE(PG8_SB(0, 1), cB + hstepB, voffB); PG8_STAGE(PG8_SA(0, 1), cA + hstepA, voffA);
        if (wr == 1) PG8_BAR;
        PG8_WAIT_V(4); PG8_BAR;
        PG8_STAGE(PG8_SB(1, 0), cB + kstep, voffB); PG8_STAGE(PG8_SA(1, 0), cA + kstep, voffA); PG8_STAGE(PG8_SB(1, 1), cB + hstepB + kstep, voffB);
        PG8_WAIT_V(6); PG8_BAR;
    }
    for (;;) {
        const bool has_next = S.next(ui + 1, nxt);
        const char* nA = has_next ? (const char*)g.A + (size_t)nxt.pm * tstepA + (size_t)nxt.kofs * 2 : cA; const char* nB = has_next ? (const char*)g.Bt + (size_t)nxt.pn * tstepB + (size_t)nxt.kofs * 2 : cB;
        if (cur.nh < 0) { PG8_KLOOP(true, true) } else { PG8_KLOOP(cur.nh != 1, cur.nh != 0) }
        if constexpr (ALIGN_EPI) { if (wr == 0) PG8_BAR; }
        if constexpr (!Epi::AFTER_DRAIN) { E(acc, cur, wr, wc, fr, fq); S.done(cur); }
        if (!has_next) break;
#pragma unroll
        for (int a = 0; a < 2; ++a)
#pragma unroll
            for (int b = 0; b < 2; ++b)
#pragma unroll
                for (int m = 0; m < 4; ++m)
#pragma unroll
                    for (int n = 0; n < 2; ++n) acc[a][b][m][n] = (f32x4){0.f, 0.f, 0.f, 0.f};
        cur = nxt; cA = nA; cB = nB; ++ui;
        if constexpr (ALIGN_EPI) { if (wr == 1) PG8_BAR; }
    }
    PG8_WAIT_V(0);
    if constexpr (!ALIGN_EPI) { if (wr == 0) PG8_BAR; }
    PG8_BAR;
    if constexpr (Epi::AFTER_DRAIN) { E.fused(acc, cur, wr, wc, fr, fq, lds, wid, lane); S.done(cur); }
#undef PG8_KLOOP
#undef PG8_SA
#undef PG8_SB
#undef PG8_STAGE
#undef PG8_LDA
#undef PG8_LDB
#undef PG8_MMA
#undef PG8_WAIT_V
#undef PG8_WAIT_L
#undef PG8_BAR
#undef PG8_SCHED
}
}
#define XB_TMO      128
#define XB_XCNT(j)  (256  + 64 * (j))
#define XB_XSUB(j)  (1280 + 64 * (j))
#define XB_XGEN(j)  (2304 + 64 * (j))
#define XB_TOP      3328
#define XB_TOPGEN   3392
#define XCD_BAR_WORDS 3456
#define XB_SPIN_CAP (1u << 18)

__device__ __forceinline__ unsigned xb_ld(unsigned* p)              { return __hip_atomic_load(p, __ATOMIC_RELAXED, __HIP_MEMORY_SCOPE_AGENT); }
__device__ __forceinline__ unsigned xb_add(unsigned* p, unsigned v) { return __hip_atomic_fetch_add(p, v, __ATOMIC_RELAXED, __HIP_MEMORY_SCOPE_AGENT); }
__device__ __forceinline__ unsigned xb_xcc_id() { return (unsigned)__builtin_amdgcn_s_getreg((3 << 11) | 20) & 0xFu; }
#define XB_SPIN(cond, bar) do { unsigned _sp = 0; while (cond) { __builtin_amdgcn_s_sleep(1); \
    if ((++_sp & 255u) == 0u) { if (xb_ld(&(bar)[XB_TMO])) break; if (_sp > XB_SPIN_CAP) { atomicAdd(&(bar)[XB_TMO], 1u); break; } } } } while (0)

struct XcdBarrier {
    unsigned* bar; unsigned x;
    volatile LAS unsigned* st;
};

__device__ __forceinline__ XcdBarrier xcd_barrier_post(unsigned* bar, volatile LAS unsigned* st) {
    XcdBarrier b; b.bar = bar; b.x = xb_xcc_id(); b.st = st;
    if (threadIdx.x == 0) (void)xb_add(&bar[XB_XCNT(b.x)], 1u);
    return b;
}
__device__ __forceinline__ void xcd_barrier_complete(unsigned* bar, unsigned x, unsigned& nloc, unsigned& nx) {
    const unsigned G = gridDim.x * gridDim.y * gridDim.z;
    unsigned sum, cnt, mine, sp = 0u;
    for (;;) {
        sum = 0u; cnt = 0u; mine = 0u;
#pragma unroll
        for (unsigned j = 0; j < 16; ++j) { const unsigned c = xb_ld(&bar[XB_XCNT(j)]); sum += c; cnt += (c > 0u) ? 1u : 0u; mine = (j == x) ? c : mine; }
        if (sum == G) break;
        __builtin_amdgcn_s_sleep(1);
        if ((++sp & 255u) == 0u) { if (xb_ld(&bar[XB_TMO])) break; if (sp > XB_SPIN_CAP) { atomicAdd(&bar[XB_TMO], 1u); break; } }
    }
    nloc = mine > 0u ? mine : 1u; nx = cnt > 0u ? cnt : 1u;
}

__device__ __forceinline__ void xcd_barrier(const XcdBarrier& b) {
    asm volatile("s_waitcnt vmcnt(0)" ::: "memory");
    __syncthreads();
    if (threadIdx.x == 0) {
        unsigned* bar = b.bar;
        __builtin_amdgcn_s_waitcnt(0);
        unsigned nloc = b.st[0], nx = b.st[1];
        if (nloc == 0u) { xcd_barrier_complete(bar, b.x, nloc, nx); b.st[0] = nloc; b.st[1] = nx; }
        const unsigned old = xb_add(&bar[XB_XSUB(b.x)], 1u);
        const unsigned gen = old / nloc;
        if (old + 1u == (gen + 1u) * nloc) {
            __builtin_amdgcn_fence(__ATOMIC_RELEASE, "agent");
            asm volatile("s_waitcnt vmcnt(0)" ::: "memory");
            const unsigned og = xb_add(&bar[XB_TOP], 1u);
            const unsigned tg = og / nx;
            if (og + 1u == (tg + 1u) * nx) xb_add(&bar[XB_TOPGEN], 1u);
            else XB_SPIN(xb_ld(&bar[XB_TOPGEN]) == tg, bar);
            __builtin_amdgcn_fence(__ATOMIC_ACQUIRE, "agent");
            xb_add(&bar[XB_XGEN(b.x)], 1u);
            asm volatile("s_waitcnt vmcnt(0)" ::: "memory");
        } else {
            XB_SPIN(xb_ld(&bar[XB_XGEN(b.x)]) == gen, bar);
            __builtin_amdgcn_fence(__ATOMIC_ACQUIRE, "agent");
            asm volatile("s_waitcnt vmcnt(0)" ::: "memory");
        }
    }
    __syncthreads();
}

typedef const float* InPtr;
typedef const __attribute__((address_space(4))) InPtr* KTab;
struct Ctx {
    KTab in; float* out; unsigned char* ws;
    LAS unsigned char* lds; int tid, lane, wave, G, bid;
    template <class T> __device__ __forceinline__ T* W(size_t off) const { return (T*)(ws + off); }
};
enum { I_XP = 0, I_XS, I_CP, I_CS, I_CK, I_CV, I_CKI, I_PT, I_SRW, I_SSH, I_SCV, I_WADA, I_BADA, I_N1G, I_N2G, I_WIN, I_MU, I_W0, I_WDEC, I_A0, I_WAUP, I_WGUP,
       I_KK, I_KA, I_RK, I_LNW, I_LNB, I_QNG, I_KNG, I_WPA, I_WPB, I_WOUT, I_WUP, I_CW, I_CB, I_WDN };

__device__ __forceinline__ void tconv(const Ctx& X, const float* __restrict__ src, int K, int N, bf16_t* __restrict__ dst, int ldd, int Kpad, int Npad) {
    const int nkt = Kpad / 128, nnt = Npad / 128, ntile = nkt * nnt;
    LAS unsigned short* tile = (LAS unsigned short*)X.lds;
    const int tid = X.tid, kr = tid >> 5, nq = tid & 31;
    f32x4 v[8];
    auto ld = [&](int ti) { const int kt = ti % nkt, nt = ti / nkt; const int k = kt * 128 + kr, n = nt * 128 + 4 * nq;
#pragma unroll
        for (int j = 0; j < 8; ++j) { v[j] = (f32x4){0.f, 0.f, 0.f, 0.f}; if (n < N && k + 16 * j < K) v[j] = *(const f32x4*)(src + (size_t)(k + 16 * j) * N + n); } };
    if (X.bid < ntile) ld(X.bid);
    for (int ti = X.bid; ti < ntile; ti += X.G) {
        const int kt = ti % nkt, nt = ti / nkt;
#pragma unroll
        for (int j = 0; j < 8; ++j) { u32x2 w; w.x = cvt_pk_bf16(v[j][0], v[j][1]); w.y = cvt_pk_bf16(v[j][2], v[j][3]); *(LAS u32x2*)(tile + (kr + 16 * j) * 132 + 4 * nq) = w; }
        __syncthreads();
        if (ti + X.G < ntile) ld(ti + X.G);
        {
            const int n = tid & 127, kg = tid >> 7;
            bf16_t* d = dst + (size_t)(nt * 128 + n) * ldd + kt * 128 + 32 * kg;
#pragma unroll
            for (int h = 0; h < 4; ++h) { unsigned short e[8];
#pragma unroll
                for (int j = 0; j < 8; ++j) e[j] = tile[(32 * kg + 8 * h + j) * 132 + n];
                u32x4 w; w.x = e[0] | ((unsigned)e[1] << 16); w.y = e[2] | ((unsigned)e[3] << 16); w.z = e[4] | ((unsigned)e[5] << 16); w.w = e[6] | ((unsigned)e[7] << 16);
                *(u32x4*)(d + 8 * h) = w; }
        }
        __syncthreads();
    }
}

__device__ __forceinline__ void ada_in_prologue(const Ctx& X) {
    constexpr int NC = 48, RT = 9, KP = 264;
    if (X.bid * NC >= MODLD) return;
    LAS bf16_t* sA = (LAS bf16_t*)X.lds;
    LAS bf16_t* sB = sA + 144 * KP;
    const int tid = X.tid, lane = X.lane, wave = X.wave, fr = lane & 15, fq = lane >> 4, n0 = X.bid * NC;
    const float* wada = X.in[I_WADA]; const float* cp = X.in[I_CP]; const float* cs = X.in[I_CS];
    f32x4 acc[4];
#pragma unroll
    for (int i = 0; i < 4; ++i) acc[i] = (f32x4){0.f, 0.f, 0.f, 0.f};
    f32x4 wv[6];
    auto ldw = [&](int kc) {
#pragma unroll
        for (int i = 0; i < 6; ++i) { const int e = tid + 512 * i, k = e / 12, n4 = (e - k * 12) * 4; wv[i] = *(const f32x4*)(wada + (size_t)(kc * 256 + k) * MODLD + n0 + n4); } };
    ldw(0);
    for (int kc = 0; kc < DM / 256; ++kc) {
#pragma unroll 6
        for (int e = tid; e < 144 * 64; e += 512) { const int r = e >> 6, k4 = (e & 63) * 4; f32x4 v = {0.f, 0.f, 0.f, 0.f};
            if (r <= DEC_B) v = *(const f32x4*)((r == 0 ? cp : cs + (size_t)(r - 1) * DM) + kc * 256 + k4);
            u32x2 w; w.x = cvt_pk_bf16(v[0] * sigmoidf_(v[0]), v[1] * sigmoidf_(v[1])); w.y = cvt_pk_bf16(v[2] * sigmoidf_(v[2]), v[3] * sigmoidf_(v[3]));
            *(LAS u32x2*)(sA + r * KP + k4) = w; }
#pragma unroll
        for (int i = 0; i < 6; ++i) { const int e = tid + 512 * i, k = e / 12, n4 = (e - k * 12) * 4;
#pragma unroll
            for (int j = 0; j < 4; ++j) sB[(n4 + j) * KP + k] = f2bf(wv[i][j]); }
        __syncthreads();
        if (kc + 1 < DM / 256) ldw(kc + 1);
#pragma unroll
        for (int i = 0; i < 4; ++i) { const int pr = wave + 8 * i;
            if (pr < RT * 3) { const int rt = pr / 3, ct = pr - rt * 3;
#pragma unroll
                for (int ks = 0; ks < 8; ++ks) { const bf16x8 a = *(const LAS bf16x8*)(sA + (rt * 16 + fr) * KP + ks * 32 + fq * 8), b = *(const LAS bf16x8*)(sB + (ct * 16 + fr) * KP + ks * 32 + fq * 8);
                    acc[i] = __builtin_amdgcn_mfma_f32_16x16x32_bf16(a, b, acc[i], 0, 0, 0); } } }
        __syncthreads();
    }
    float* MOD = X.W<float>(WS_MOD);
#pragma unroll
    for (int i = 0; i < 4; ++i) { const int pr = wave + 8 * i;
        if (pr < RT * 3) { const int rt = pr / 3, ct = pr - rt * 3, n = n0 + ct * 16 + fr; const float bias = X.in[I_BADA][n];
#pragma unroll
            for (int j = 0; j < 4; ++j) { const int r = rt * 16 + 4 * fq + j; if (r <= DEC_B) MOD[(size_t)r * MODLD + n] = acc[i][j] + bias; } } }
}

__device__ __forceinline__ void phase_convert(const Ctx& X) {
    tconv(X, X.in[I_WIN], DM, IN_COLS, X.W<bf16_t>(WS_WIN), DM, DM, ZLD);
    tconv(X, X.in[I_WDEC], 96, DM, X.W<bf16_t>(WS_WDEC), 256, 256, DM);
    tconv(X, X.in[I_WAUP], 96, DM, X.W<bf16_t>(WS_WA), 256, 256, DM);
    tconv(X, X.in[I_WGUP], 256, DM, X.W<bf16_t>(WS_WG), 256, 256, DM);
    ada_in_prologue(X);
}

__device__ __forceinline__ void phase_norm_mod(const Ctx& X, const float* xp, const float* xs, const float* gn, int sh_off, int sc_off, bf16_t* dst) {
    const float* MOD = X.W<float>(WS_MOD);
    const int lane = X.lane;
    auto ld = [&](int t, f32x4 (&v)[8]) { const float* x = t < SEQ ? xp + (size_t)t * DM : xs + (size_t)(t - SEQ) * DM;
#pragma unroll
        for (int i = 0; i < 8; ++i) v[i] = ((const f32x4*)x)[lane + 64 * i]; };
    f32x4 v[8], v1[8];
    const int t0 = X.bid * 8 + X.wave, ts = X.G * 8;
    if (t0 < NTOK) ld(t0, v);
    if (t0 + ts < NTOK) ld(t0 + ts, v1); else {
#pragma unroll
        for (int i = 0; i < 8; ++i) v1[i] = v[i]; }
    for (int t = t0; t < NTOK; t += ts) {
        const float* mr = MOD + (size_t)(t < SEQ ? 0 : 1 + ((t - SEQ) >> 3)) * MODLD;
        f32x4 v2[8];
#pragma unroll
        for (int i = 0; i < 8; ++i) v2[i] = v1[i];
        if (t + 2 * ts < NTOK) ld(t + 2 * ts, v2);
        float ss = 0.f;
#pragma unroll
        for (int i = 0; i < 8; ++i) ss += v[i][0] * v[i][0] + v[i][1] * v[i][1] + v[i][2] * v[i][2] + v[i][3] * v[i][3];
        ss = wave_sum(ss);
        const float rs = rsqrtf(ss * (1.f / DM) + 1e-6f);
#pragma unroll
        for (int i = 0; i < 8; ++i) { const int c = 4 * (lane + 64 * i);
            const f32x4 g = *(const f32x4*)(gn + c), sc = *(const f32x4*)(mr + sc_off + c), sh = *(const f32x4*)(mr + sh_off + c);
            f32x4 y;
#pragma unroll
            for (int e = 0; e < 4; ++e) y[e] = v[i][e] * rs * g[e] * (1.f + sc[e]) + sh[e];
            u32x2 w; w.x = cvt_pk_bf16(y[0], y[1]); w.y = cvt_pk_bf16(y[2], y[3]);
            *(u32x2*)(dst + (size_t)t * DM + c) = w; }
#pragma unroll
        for (int i = 0; i < 8; ++i) { v[i] = v1[i]; v1[i] = v2[i]; }
    }
}

__device__ __forceinline__ void phase_prep1(const Ctx& X) {
    const bf16_t* Z = X.W<bf16_t>(WS_Z);
    const float* mu = X.in[I_MU];
    bf16_t* ADEC = X.W<bf16_t>(WS_ADEC); bf16_t* AAIN = X.W<bf16_t>(WS_AAIN); bf16_t* AGIN = X.W<bf16_t>(WS_AGIN);
    bf16_t* QB = X.W<bf16_t>(WS_QB); bf16_t* KB = X.W<bf16_t>(WS_KB); bf16_t* VB = X.W<bf16_t>(WS_VB); bf16_t* KIB = X.W<bf16_t>(WS_KIB); float* WI = X.W<float>(WS_WI);
    const int lane = X.lane;
    struct Raw { float zc[7], zp[7]; u32x4 q[4], k, v, ki; float wi; };
    auto load = [&](int t, Raw& R) {
        const bf16_t* zr = Z + (size_t)t * ZLD;
        const bool smp = t >= SEQ; const int tt = smp ? t - SEQ : t; const int p = smp ? (tt & 7) : t; const int b = tt >> 3;
#pragma unroll
        for (int i = 0; i < 7; ++i) { const int c = C_WD + lane + 64 * i;
            R.zc[i] = bf2f(zr[c]);
            float zp = 0.f; if (p > 0) zp = bf2f(zr[c - ZLD]); else if (smp) zp = X.in[I_SSH][(size_t)b * SHIFT_W + c];
            R.zp[i] = zp; }
#pragma unroll
        for (int i = 0; i < 4; ++i) R.q[i] = *(const u32x4*)(zr + C_Q + 8 * (lane + 64 * i));
        R.k = *(const u32x4*)(zr + C_KK + 8 * lane); R.v = *(const u32x4*)(zr + C_VV + 8 * lane);
        R.ki = *(const u32x4*)(zr + C_KI + 8 * (lane & 7)); R.wi = bf2f(zr[C_WI + (lane & 15)]); };
    Raw R;
    const int t0 = X.bid * 8 + X.wave;
    if (t0 < NTOK) load(t0, R);
    for (int t = t0; t < NTOK; t += X.G * 8) {
        Raw Rn = R;
        if (t + X.G * 8 < NTOK) load(t + X.G * 8, Rn);
        const bf16_t* zr = Z + (size_t)t * ZLD;
        const bool smp = t >= SEQ; const int tt = smp ? t - SEQ : t; const int p = smp ? (tt & 7) : t; const int b = tt >> 3;
#pragma unroll
        for (int i = 0; i < 7; ++i) { const int c = C_WD + lane + 64 * i;
            const float zc = R.zc[i], zp = R.zp[i];
            const float zs = zc + (zp - zc) * mu[c];
            if (c < C_AD) ADEC[(size_t)t * 256 + (c - C_WD)] = f2bf(tanhf(zs));
            else if (c < C_GD) AAIN[(size_t)t * 256 + (c - C_AD)] = f2bf(zs);
            else AGIN[(size_t)t * 256 + (c - C_GD)] = f2bf(sigmoidf_(zs)); }
        for (int c = 96 + lane; c < 256; c += 64) { ADEC[(size_t)t * 256 + c] = 0; AAIN[(size_t)t * 256 + c] = 0; }
#pragma unroll
        for (int i = 0; i < 4; ++i) { const int e = 8 * (lane + 64 * i); float f[8]; unpack8(R.q[i], f);
            float ss = 0.f;
#pragma unroll
            for (int j = 0; j < 8; ++j) ss += f[j] * f[j];
            ss = row16_sum(ss); const float rs = rsqrtf(ss * (1.f / 128.f) + 1e-6f) * 0.08838834764831845f;
            const float* g = X.in[I_QNG] + (e & 127);
#pragma unroll
            for (int j = 0; j < 8; ++j) f[j] = f[j] * rs * g[j];
            *(u32x4*)(QB + (size_t)t * DM + e) = pack8(f);
            if (!smp) {
#pragma unroll
                for (int j = 0; j < 8; ++j) f[j] *= 11.313708498984761f;
                *(u32x2*)(X.W<unsigned char>(WS_Q8) + (size_t)t * DM + e) = pack8_fp8(f); } }
        { const int e = 8 * lane; float f[8]; unpack8(R.k, f);
            float ss = 0.f;
#pragma unroll
            for (int j = 0; j < 8; ++j) ss += f[j] * f[j];
            ss = row16_sum(ss); const float rs = rsqrtf(ss * (1.f / 128.f) + 1e-6f);
            const float* g = X.in[I_KNG] + (e & 127);
#pragma unroll
            for (int j = 0; j < 8; ++j) f[j] = f[j] * rs * g[j];
            *(u32x4*)(KB + (size_t)t * 512 + e) = pack8(f);
            if (!smp) { const int d0 = e & 127; *(u32x2*)(X.W<unsigned char>(WS_K8) + (size_t)(e >> 7) * (SEQ * 128) + (size_t)t * 128 + (d0 >> 6) * 64 + ((d0 >> 3) & 3) * 16 + ((d0 >> 5) & 1) * 8) = pack8_fp8(f); }
            float* ko = X.out + (smp ? O_KS : O_KP) + (size_t)tt * 512 + e;
            *(f32x4*)ko = (f32x4){f[0], f[1], f[2], f[3]}; *(f32x4*)(ko + 4) = (f32x4){f[4], f[5], f[6], f[7]};
            const u32x4 vw = R.v; unpack8(vw, f);
            *(u32x4*)(VB + (size_t)t * 512 + e) = vw;
            if (!smp) *(u32x2*)(X.W<unsigned char>(WS_V8) + (size_t)(e >> 7) * (SEQ * 128) + (size_t)t * 128 + (e & 127)) = pack8_fp8(f);
            float* vo = X.out + (smp ? O_VS : O_VP) + (size_t)tt * 512 + e;
            *(f32x4*)vo = (f32x4){f[0], f[1], f[2], f[3]}; *(f32x4*)(vo + 4) = (f32x4){f[4], f[5], f[6], f[7]}; }
        if (lane < 8) { const int e = 8 * lane; float f[8]; const u32x4 kw = R.ki; unpack8(kw, f);
            *(u32x4*)((unsigned char*)KIB + (size_t)(t >> 5) * 4096 + (lane >> 1) * 1024 + ((t & 31) + 32 * (lane & 1)) * 16) = kw;
            float* ko = X.out + (smp ? O_KIS : O_KIP) + (size_t)tt * 64 + e;
            *(f32x4*)ko = (f32x4){f[0], f[1], f[2], f[3]}; *(f32x4*)(ko + 4) = (f32x4){f[4], f[5], f[6], f[7]}; }
        if (lane < 16) WI[(size_t)t * 16 + lane] = R.wi * 0.03125f;
        if (t == SEQ - 1 || (smp && p == 7)) { float* so = X.out + (smp ? O_SHS + (size_t)b * SHIFT_W : O_SHP);
#pragma unroll
            for (int i = 0; i < 13; ++i) { const int c8 = lane + 64 * i;
                if (c8 < SHIFT_W / 8) { float f[8]; unpack8(*(const u32x4*)(zr + 8 * c8), f); *(f32x4*)(so + 8 * c8) = (f32x4){f[0], f[1], f[2], f[3]}; *(f32x4*)(so + 8 * c8 + 4) = (f32x4){f[4], f[5], f[6], f[7]}; } } }
        R = Rn;
    }
}

__device__ __forceinline__ void phase_prep2(const Ctx& X) {
    const bf16_t* Z = X.W<bf16_t>(WS_Z); const bf16_t* AAO = X.W<bf16_t>(WS_AAO);
    const float* mu = X.in[I_MU];
    bf16_t* RS = X.W<bf16_t>(WS_RS); bf16_t* KS = X.W<bf16_t>(WS_KS); bf16_t* VS = X.W<bf16_t>(WS_VS); bf16_t* AS = X.W<bf16_t>(WS_AS); bf16_t* BS = X.W<bf16_t>(WS_BS);
    float* BON = X.W<float>(WS_BON);
    const int lane = X.lane;
    for (int t = SEQ + X.bid * 8 + X.wave; t < NTOK; t += X.G * 8) {
        const bf16_t* zr = Z + (size_t)t * ZLD;
        const bool smp = t >= SEQ; const int tt = smp ? t - SEQ : t; const int p = smp ? (tt & 7) : t; const int b = tt >> 3;
        const float* sprev = X.in[I_SSH] + (size_t)b * SHIFT_W;
#pragma unroll
        for (int i = 0; i < 4; ++i) { const int e = 8 * (lane + 64 * i);
            float r[8], k[8], v[8], a[8], pr[8], pk[8], pv[8];
            unpack8(*(const u32x4*)(zr + C_R + e), r); unpack8(*(const u32x4*)(zr + C_K + e), k); unpack8(*(const u32x4*)(zr + C_V + e), v);
            unpack8(*(const u32x4*)(AAO + (size_t)t * DM + e), a);
            if (p > 0) { unpack8(*(const u32x4*)(zr - ZLD + C_R + e), pr); unpack8(*(const u32x4*)(zr - ZLD + C_K + e), pk); unpack8(*(const u32x4*)(zr - ZLD + C_V + e), pv); }
            else if (smp) {
#pragma unroll
                for (int j = 0; j < 8; ++j) { pr[j] = sprev[C_R + e + j]; pk[j] = sprev[C_K + e + j]; pv[j] = sprev[C_V + e + j]; } }
            else {
#pragma unroll
                for (int j = 0; j < 8; ++j) { pr[j] = 0.f; pk[j] = 0.f; pv[j] = 0.f; } }
            float kk[8], kp[8], bs[8], ss = 0.f, bo = 0.f;
#pragma unroll
            for (int j = 0; j < 8; ++j) {
                r[j] = r[j] + (pr[j] - r[j]) * mu[C_R + e + j]; k[j] = k[j] + (pk[j] - k[j]) * mu[C_K + e + j]; v[j] = v[j] + (pv[j] - v[j]) * mu[C_V + e + j];
                kk[j] = k[j] * X.in[I_KK][e + j]; ss += kk[j] * kk[j];
                kp[j] = k[j] * (1.f + (a[j] - 1.f) * X.in[I_KA][e + j]);
                bo += r[j] * kp[j] * X.in[I_RK][e + j]; }
            ss = row8_sum(ss); bo = row8_sum(bo);
            const float inv = 1.f / fmaxf(sqrtf(ss), 1e-12f);
#pragma unroll
            for (int j = 0; j < 8; ++j) { kk[j] *= inv; bs[j] = kk[j] * a[j]; kk[j] = -kk[j]; }
            *(u32x4*)(RS + (size_t)t * DM + e) = pack8(r); *(u32x4*)(KS + (size_t)t * DM + e) = pack8(kp); *(u32x4*)(VS + (size_t)t * DM + e) = pack8(v);
            *(u32x4*)(AS + (size_t)t * DM + e) = pack8(kk); *(u32x4*)(BS + (size_t)t * DM + e) = pack8(bs);
            if ((lane & 7) == 0) BON[(size_t)t * 32 + (e >> 6)] = bo; }
    }
}

constexpr int SCAN_STEP = 512;
constexpr int SCAN_WLDS = 8 * SCAN_STEP * 4 + 6 * 64 * 4;
struct ScanRegs { u32x4 v[7]; float bon; };
__device__ __forceinline__ void scan_load(const Ctx& X, ScanRegs& R, int tok0, int h, int lane, bool need_r, bool need_v, bool need_g) {
    const size_t off = (size_t)(tok0 + (lane >> 3)) * DM + h * 64 + (lane & 7) * 8;
    R.v[0] = *(const u32x4*)(X.W<bf16_t>(WS_AS) + off); R.v[1] = *(const u32x4*)(X.W<bf16_t>(WS_LW) + off); R.v[2] = *(const u32x4*)(X.W<bf16_t>(WS_BS) + off);
    R.v[3] = *(const u32x4*)(X.W<bf16_t>(WS_KS) + off);
    if (need_r) R.v[4] = *(const u32x4*)(X.W<bf16_t>(WS_RS) + off);
    if (need_v) R.v[5] = *(const u32x4*)(X.W<bf16_t>(WS_VS) + off);
    if (need_g) { R.v[6] = *(const u32x4*)(X.W<bf16_t>(WS_GG) + off); R.bon = X.W<float>(WS_BON)[(size_t)(tok0 + (lane & 7)) * 32 + h]; }
}
__device__ __forceinline__ void scan_store(LAS float* wl, const ScanRegs& R, int lane, bool need_r, bool need_v, bool need_g) {
    LAS float* base = wl + (lane >> 3) * SCAN_STEP + (lane & 7) * 8;
    if (need_g && lane < 8) wl[lane * SCAN_STEP + 448] = R.bon;
#pragma unroll
    for (int vi = 0; vi < 7; ++vi) {
        if ((vi == 4 && !need_r) || (vi == 5 && !need_v) || (vi == 6 && !need_g)) continue;
        float f[8]; unpack8(R.v[vi], f);
        if (vi == 1) {
#pragma unroll
            for (int j = 0; j < 8; ++j) f[j] = __expf(f[j]); }
        *(LAS f32x4*)(base + vi * 64) = (f32x4){f[0], f[1], f[2], f[3]}; *(LAS f32x4*)(base + vi * 64 + 4) = (f32x4){f[4], f[5], f[6], f[7]};
    }
}
#define CBAR() asm volatile("" ::: "memory")
template <bool HAS_V, bool HAS_OUT>
__device__ __forceinline__ float scan_step(float (&S)[64], const LAS float* sv, int lane) {
    const LAS f32x4* A4 = (const LAS f32x4*)sv;
    float s0 = 0.f, s1 = 0.f, s2 = 0.f, s3 = 0.f;
#pragma unroll
    for (int q = 0; q < 16; ++q) { const f32x4 a = A4[q]; s0 = fmaf(S[4 * q], a[0], s0); s1 = fmaf(S[4 * q + 1], a[1], s1); s2 = fmaf(S[4 * q + 2], a[2], s2); s3 = fmaf(S[4 * q + 3], a[3], s3);
        if ((q & 7) == 7) CBAR(); }
    const float sa = (s0 + s1) + (s2 + s3);
    const float vi = HAS_V ? sv[320 + lane] : 0.f;
    float o0 = 0.f, o1 = 0.f, o2 = 0.f, o3 = 0.f;
#pragma unroll
    for (int q = 0; q < 16; ++q) { const f32x4 w = A4[16 + q], b = A4[32 + q];
        if (HAS_V) { const f32x4 k = A4[48 + q];
            S[4 * q] = fmaf(S[4 * q], w[0], fmaf(sa, b[0], vi * k[0])); S[4 * q + 1] = fmaf(S[4 * q + 1], w[1], fmaf(sa, b[1], vi * k[1]));
            S[4 * q + 2] = fmaf(S[4 * q + 2], w[2], fmaf(sa, b[2], vi * k[2])); S[4 * q + 3] = fmaf(S[4 * q + 3], w[3], fmaf(sa, b[3], vi * k[3]));
        } else {
            S[4 * q] = fmaf(S[4 * q], w[0], sa * b[0]); S[4 * q + 1] = fmaf(S[4 * q + 1], w[1], sa * b[1]);
            S[4 * q + 2] = fmaf(S[4 * q + 2], w[2], sa * b[2]); S[4 * q + 3] = fmaf(S[4 * q + 3], w[3], sa * b[3]); }
        if (HAS_OUT) { const f32x4 r = A4[64 + q]; o0 = fmaf(S[4 * q], r[0], o0); o1 = fmaf(S[4 * q + 1], r[1], o1); o2 = fmaf(S[4 * q + 2], r[2], o2); o3 = fmaf(S[4 * q + 3], r[3], o3); }
        if ((q & 3) == 3) CBAR();
    }
    return (o0 + o1) + (o2 + o3);
}

__device__ __forceinline__ void scan_step_dual(float (&Su)[64], float (&Sp)[64], const LAS float* sv, int lane, float& ur, float& qv) {
    const LAS f32x4* A4 = (const LAS f32x4*)sv;
    float u0 = 0.f, u1 = 0.f, u2 = 0.f, u3 = 0.f, p0 = 0.f, p1 = 0.f, p2 = 0.f, p3 = 0.f;
#pragma unroll
    for (int q = 0; q < 16; ++q) { const f32x4 a = A4[q];
        u0 = fmaf(Su[4 * q], a[0], u0); u1 = fmaf(Su[4 * q + 1], a[1], u1); u2 = fmaf(Su[4 * q + 2], a[2], u2); u3 = fmaf(Su[4 * q + 3], a[3], u3);
        p0 = fmaf(Sp[4 * q], a[0], p0); p1 = fmaf(Sp[4 * q + 1], a[1], p1); p2 = fmaf(Sp[4 * q + 2], a[2], p2); p3 = fmaf(Sp[4 * q + 3], a[3], p3);
        if ((q & 7) == 7) CBAR(); }
    const float sau = (u0 + u1) + (u2 + u3), sap = (p0 + p1) + (p2 + p3);
    const float vi = sv[320 + lane];
#pragma unroll
    for (int q = 0; q < 16; ++q) { const f32x4 w = A4[16 + q], b = A4[32 + q], k = A4[48 + q];
#pragma unroll
        for (int e = 0; e < 4; ++e) { Su[4 * q + e] = fmaf(Su[4 * q + e], w[e], fmaf(sau, b[e], vi * k[e])); Sp[4 * q + e] = fmaf(Sp[4 * q + e], w[e], sap * b[e]); }
        if ((q & 1) == 1) CBAR();
    }
    float x0 = 0.f, x1 = 0.f, x2 = 0.f, x3 = 0.f, y0 = 0.f, y1 = 0.f, y2 = 0.f, y3 = 0.f;
#pragma unroll
    for (int q = 0; q < 16; ++q) { const f32x4 r = A4[64 + q];
        x0 = fmaf(Su[4 * q], r[0], x0); x1 = fmaf(Su[4 * q + 1], r[1], x1); x2 = fmaf(Su[4 * q + 2], r[2], x2); x3 = fmaf(Su[4 * q + 3], r[3], x3);
        y0 = fmaf(Sp[4 * q], r[0], y0); y1 = fmaf(Sp[4 * q + 1], r[1], y1); y2 = fmaf(Sp[4 * q + 2], r[2], y2); y3 = fmaf(Sp[4 * q + 3], r[3], y3);
        if ((q & 7) == 7) CBAR(); }
    ur = (x0 + x1) + (x2 + x3); qv = (y0 + y1) + (y2 + y3);
}
struct ScanRaw { u32x4 zr, zk, zv, pr, pk, pv, aa, lw; };
__device__ __forceinline__ void scanA_load(const Ctx& X, ScanRaw& R, int tok0, int h, int lane) {
    const unsigned t = tok0 + (lane >> 3), c = h * 64 + (lane & 7) * 8;
    const unsigned char* zb = X.ws + WS_Z;
    const unsigned zo = (t * ZLD + c) * 2u, ao = (t * DM + c) * 2u;
    R.zr = *(const u32x4*)(zb + (zo + C_R * 2u)); R.zk = *(const u32x4*)(zb + (zo + C_K * 2u)); R.zv = *(const u32x4*)(zb + (zo + C_V * 2u));
    if (t > 0) { const unsigned po = zo - ZLD * 2u; R.pr = *(const u32x4*)(zb + (po + C_R * 2u)); R.pk = *(const u32x4*)(zb + (po + C_K * 2u)); R.pv = *(const u32x4*)(zb + (po + C_V * 2u)); }
    else { R.pr = (u32x4){0u, 0u, 0u, 0u}; R.pk = R.pr; R.pv = R.pr; }
    R.aa = *(const u32x4*)(X.ws + WS_AAO + ao); R.lw = *(const u32x4*)(X.ws + WS_LW + ao);
}
__device__ __forceinline__ void scanA_store(const Ctx& X, LAS float* wl, const LAS float* cst, const ScanRaw& R, int tok0, int h, int lane) {
    const int part = lane & 7, t = tok0 + (lane >> 3);
    LAS float* base = wl + (lane >> 3) * SCAN_STEP + part * 8;
    const LAS float* cp = cst + part * 8;
    float x[8], px[8], r[8], k[8], a[8];
    auto lerp_to = [&](const u32x4 cur, const u32x4 prev, int ci, float (&o)[8]) { unpack8(cur, x); unpack8(prev, px);
        const f32x4 m0 = *(const LAS f32x4*)(cp + ci * 64), m1 = *(const LAS f32x4*)(cp + ci * 64 + 4);
#pragma unroll
        for (int j = 0; j < 4; ++j) { o[j] = x[j] + (px[j] - x[j]) * m0[j]; o[4 + j] = x[4 + j] + (px[4 + j] - x[4 + j]) * m1[j]; } };
    { float v[8]; lerp_to(R.zv, R.pv, 2, v);
      *(LAS f32x4*)(base + 5 * 64) = (f32x4){v[0], v[1], v[2], v[3]}; *(LAS f32x4*)(base + 5 * 64 + 4) = (f32x4){v[4], v[5], v[6], v[7]};
      *(u32x4*)(X.ws + WS_VS + ((unsigned)(t * DM + h * 64 + part * 8) * 2u)) = pack8(v); }
    CBAR();
    { unpack8(R.lw, x);
#pragma unroll
      for (int j = 0; j < 8; ++j) x[j] = __expf(x[j]);
      *(LAS f32x4*)(base + 1 * 64) = (f32x4){x[0], x[1], x[2], x[3]}; *(LAS f32x4*)(base + 1 * 64 + 4) = (f32x4){x[4], x[5], x[6], x[7]}; }
    CBAR();
    lerp_to(R.zr, R.pr, 0, r);
    *(LAS f32x4*)(base + 4 * 64) = (f32x4){r[0], r[1], r[2], r[3]}; *(LAS f32x4*)(base + 4 * 64 + 4) = (f32x4){r[4], r[5], r[6], r[7]};
    CBAR();
    lerp_to(R.zk, R.pk, 1, k);
    unpack8(R.aa, a);
    float kk[8], ss = 0.f, bo = 0.f;
    { const f32x4 c0 = *(const LAS f32x4*)(cp + 3 * 64), c1 = *(const LAS f32x4*)(cp + 3 * 64 + 4), d0 = *(const LAS f32x4*)(cp + 4 * 64), d1 = *(const LAS f32x4*)(cp + 4 * 64 + 4);
#pragma unroll
      for (int j = 0; j < 8; ++j) { const float kkc = j < 4 ? c0[j & 3] : c1[j & 3], kac = j < 4 ? d0[j & 3] : d1[j & 3];
          kk[j] = k[j] * kkc; ss += kk[j] * kk[j];
          k[j] = k[j] * (1.f + (a[j] - 1.f) * kac); } }
    *(LAS f32x4*)(base + 3 * 64) = (f32x4){k[0], k[1], k[2], k[3]}; *(LAS f32x4*)(base + 3 * 64 + 4) = (f32x4){k[4], k[5], k[6], k[7]};
    { const f32x4 e0 = *(const LAS f32x4*)(cp + 5 * 64), e1 = *(const LAS f32x4*)(cp + 5 * 64 + 4), r0 = *(const LAS f32x4*)(base + 4 * 64), r1 = *(const LAS f32x4*)(base + 4 * 64 + 4);
#pragma unroll
      for (int j = 0; j < 4; ++j) bo += r0[j] * k[j] * e0[j] + r1[j] * k[4 + j] * e1[j]; }
    CBAR();
    ss = row8_sum(ss); bo = row8_sum(bo);
    const float inv = 1.f / fmaxf(sqrtf(ss), 1e-12f);
#pragma unroll
    for (int j = 0; j < 8; ++j) { kk[j] *= inv; a[j] *= kk[j]; kk[j] = -kk[j]; }
    *(LAS f32x4*)(base + 0 * 64) = (f32x4){kk[0], kk[1], kk[2], kk[3]}; *(LAS f32x4*)(base + 0 * 64 + 4) = (f32x4){kk[4], kk[5], kk[6], kk[7]};
    *(LAS f32x4*)(base + 2 * 64) = (f32x4){a[0], a[1], a[2], a[3]}; *(LAS f32x4*)(base + 2 * 64 + 4) = (f32x4){a[4], a[5], a[6], a[7]};
    if (part == 0) *(float*)(X.ws + WS_BON + ((unsigned)(t * 32 + h) * 4u)) = bo;
}
__device__ __forceinline__ void phase_scan_a(const Ctx& X) {
    LAS float* wl = (LAS float*)(X.lds + X.wave * SCAN_WLDS);
    LAS float* cst = wl + 8 * SCAN_STEP;
    float* PC = X.W<float>(WS_PC); float* UC = X.W<float>(WS_UC);
    const int lane = X.lane;
    for (int task = X.bid * 8 + X.wave; task < NCHUNK * 32; task += X.G * 8) {
        const int c = task >> 5, h = task & 31, tok0 = c * CHUNK;
        float Su[64], Sp[64];
        int ln = lane; asm volatile("" : "+v"(ln));
#pragma unroll
        for (int j = 0; j < 64; ++j) { Su[j] = 0.f; Sp[j] = (j == ln) ? 1.f : 0.f; }
        { const int ch = h * 64 + lane; const float* mu = X.in[I_MU];
          cst[lane] = mu[C_R + ch]; cst[64 + lane] = mu[C_K + ch]; cst[128 + lane] = mu[C_V + ch];
          cst[192 + lane] = X.in[I_KK][ch]; cst[256 + lane] = X.in[I_KA][ch]; cst[320 + lane] = X.in[I_RK][ch]; }
        ScanRaw R; scanA_load(X, R, tok0, h, ln);
        unsigned char* QU = X.ws + WS_QV;
        wave_sync();
        for (int sb = 0; sb < CHUNK / 8; ++sb) {
            int l2 = lane; asm volatile("" : "+v"(l2));
            scanA_store(X, wl, cst, R, tok0 + 8 * sb, h, l2);
            wave_sync();
            if (sb + 1 < CHUNK / 8) scanA_load(X, R, tok0 + 8 * (sb + 1), h, l2);
            unsigned qo = (unsigned)((tok0 + 8 * sb) * DM + h * 64 + l2) * 4u;
#pragma unroll 1
            for (int s = 0; s < 8; ++s) { float ur, qv; scan_step_dual(Su, Sp, wl + s * SCAN_STEP, lane, ur, qv);
                *(unsigned*)(QU + qo) = cvt_pk_bf16(qv, ur); qo += DM * 4u; }
            wave_sync();
        }
        float* du = UC + (size_t)(c * 32 + h) * 4096 + ln; float* dp = PC + (size_t)(c * 32 + h) * 4096 + ln;
#pragma unroll
        for (int j = 0; j < 64; ++j) du[j * 64] = Su[j];
#pragma unroll
        for (int j = 0; j < 64; ++j) dp[j * 64] = Sp[j];
    }
}

__device__ __forceinline__ void phase_scan_b(const Ctx& X) {
    if (X.bid >= 32) return;
    const int h = X.bid, lane = X.lane, w = X.wave, n16 = lane & 15, kq = lane >> 4;
    LAS float* sS = (LAS float*)X.lds;
    const float* PC = X.W<float>(WS_PC); const float* UC = X.W<float>(WS_UC); float* SC = X.W<float>(WS_SC);
    for (int i = X.tid; i < 2 * 64 * 68; i += 512) sS[i] = 0.f;
    constexpr int PD = 6;
    float pb[PD][16]; f32x4 ub[PD][2];
    const int cb = w & 3, r0 = w >> 2;
    auto ldp = [&](int c, float (&p)[16], f32x4 (&u)[2]) { const float* pc = PC + (size_t)(c * 32 + h) * 4096 + (16 * cb + n16) * 64 + 16 * kq;
#pragma unroll
        for (int q4 = 0; q4 < 4; ++q4) { const f32x4 v = *(const f32x4*)(pc + 4 * q4); p[4 * q4] = v[0]; p[4 * q4 + 1] = v[1]; p[4 * q4 + 2] = v[2]; p[4 * q4 + 3] = v[3]; }
#pragma unroll
        for (int g = 0; g < 2; ++g) u[g] = *(const f32x4*)(UC + (size_t)(c * 32 + h) * 4096 + (16 * cb + n16) * 64 + 16 * (r0 + 2 * g) + 4 * kq); };
#pragma unroll
    for (int d = 0; d < PD; ++d) ldp(d, pb[d], ub[d]);
    __syncthreads();
    auto step = [&](int c, float (&p)[16], f32x4 (&u)[2]) {
        const LAS float* cur = sS + (c & 1) * 4352; LAS float* nxt = sS + ((c + 1) & 1) * 4352;
        const LAS float* a0 = cur + (16 * r0 + n16) * 68 + 16 * kq; const LAS float* a1 = a0 + 32 * 68;
        f32x4 x0 = u[0], x1 = {0.f, 0.f, 0.f, 0.f}, y0 = u[1], y1 = {0.f, 0.f, 0.f, 0.f};
#pragma unroll
        for (int kk = 0; kk < 16; kk += 2) {
            x0 = __builtin_amdgcn_mfma_f32_16x16x4f32(a0[kk], p[kk], x0, 0, 0, 0);
            y0 = __builtin_amdgcn_mfma_f32_16x16x4f32(a1[kk], p[kk], y0, 0, 0, 0);
            x1 = __builtin_amdgcn_mfma_f32_16x16x4f32(a0[kk + 1], p[kk + 1], x1, 0, 0, 0);
            y1 = __builtin_amdgcn_mfma_f32_16x16x4f32(a1[kk + 1], p[kk + 1], y1, 0, 0, 0); }
        const f32x4 sx = x0 + x1, sy = y0 + y1;
        ldp(c + PD < NCHUNK ? c + PD : NCHUNK - 1, p, u);
        float* dst = SC + (size_t)(((c + 1) & (NCHUNK - 1)) * 32 + h) * 4096 + (16 * cb + n16) * 64 + 16 * r0 + 4 * kq;
        *(f32x4*)dst = sx; *(f32x4*)(dst + 32) = sy;
#pragma unroll
        for (int j = 0; j < 4; ++j) { const int rx = 16 * r0 + 4 * kq + j, col = 16 * cb + n16;
            nxt[rx * 68 + col] = sx[j]; nxt[(rx + 32) * 68 + col] = sy[j]; }
        __syncthreads(); };
    constexpr int NFULL = NCHUNK / PD * PD;
#pragma unroll 1
    for (int c0 = 0; c0 < NFULL; c0 += PD) {
#pragma unroll
        for (int d = 0; d < PD; ++d) step(c0 + d, pb[d], ub[d]);
    }
#pragma unroll
    for (int d = 0; d < NCHUNK - NFULL; ++d) step(NFULL + d, pb[d], ub[d]);
    { const LAS float* fin = sS + (NCHUNK & 1) * 4352; float* o = X.out + O_RWP + (size_t)h * 4096;
      for (int i = X.tid; i < 4096; i += 512) o[i] = fin[(i >> 6) * 68 + (i & 63)]; }
}

__device__ __forceinline__ void scan_c_finish(float o, const LAS float* st, float lw, float lb, int lane, bf16_t* dst) {
    const float mean = wave_sum(o) * (1.f / 64.f), d = o - mean, var = wave_sum(d * d) * (1.f / 64.f);
    const float on = d * rsqrtf(var + 64e-5f) * lw + lb;
    const float vi = st[320 + lane], g = st[384 + lane], bon = st[448];
    *dst = f2bf((on + bon * vi) * g);
}
__device__ __forceinline__ void phase_scan_c(const Ctx& X) {
    LAS float* wl = (LAS float*)(X.lds + X.wave * SCAN_WLDS);
    const float* SC = X.W<float>(WS_SC); bf16_t* OC = X.W<bf16_t>(WS_OCAT);
    int lane = X.lane; asm volatile("" : "+v"(lane));
    for (int id = X.bid * 8 + X.wave; id < NCHUNK * 32 + DEC_B * 32; id += X.G * 8) {
        const bool smp = id >= NCHUNK * 32; const int task = smp ? id - NCHUNK * 32 : id, cb = task >> 5, h = task & 31;
        const int tok0 = smp ? SEQ + cb * 8 : cb * CHUNK, nsb = smp ? 1 : CHUNK / 8;
        float S[64];
        if (smp) { const float* s0 = X.in[I_SRW] + ((size_t)(cb * 32 + h) * 64 + lane) * 64;
#pragma unroll
            for (int q = 0; q < 16; ++q) { const f32x4 v = *(const f32x4*)(s0 + 4 * q); S[4 * q] = v[0]; S[4 * q + 1] = v[1]; S[4 * q + 2] = v[2]; S[4 * q + 3] = v[3]; }
        } else if (cb > 0) { const float* s0 = SC + (size_t)(cb * 32 + h) * 4096 + lane;
#pragma unroll
            for (int j = 0; j < 64; ++j) S[j] = s0[j * 64];
        } else {
#pragma unroll
            for (int j = 0; j < 64; ++j) S[j] = 0.f; }
        const float lw = X.in[I_LNW][h * 64 + lane], lb = X.in[I_LNB][h * 64 + lane];
        if (smp) {
            ScanRegs R; scan_load(X, R, tok0, h, lane, true, true, true);
            scan_store(wl, R, lane, true, true, true);
            wave_sync();
#pragma unroll 1
            for (int s = 0; s < 8; ++s) { const float o = scan_step<true, true>(S, wl + s * SCAN_STEP, lane);
                scan_c_finish(o, wl + s * SCAN_STEP, lw, lb, lane, OC + (size_t)(tok0 + s) * 4096 + h * 64 + lane); }
            wave_sync();
            float* dst = X.out + O_RWS + ((size_t)(cb * 32 + h) * 64 + lane) * 64;
#pragma unroll
            for (int q = 0; q < 16; ++q) *(f32x4*)(dst + 4 * q) = (f32x4){S[4 * q], S[4 * q + 1], S[4 * q + 2], S[4 * q + 3]};
        } else {
            u32x4 rq, ru, rv, rg; float rb;
            auto ld = [&](int t0) { const size_t off = (size_t)(t0 + (lane >> 3)) * DM + h * 64 + (lane & 7) * 8;
                rq = *(const u32x4*)(X.W<unsigned>(WS_QV) + off); ru = *(const u32x4*)(X.W<unsigned>(WS_QV) + off + 4); rv = *(const u32x4*)(X.W<bf16_t>(WS_VS) + off); rg = *(const u32x4*)(X.W<bf16_t>(WS_GG) + off);
                rb = X.W<float>(WS_BON)[(size_t)(t0 + (lane & 7)) * 32 + h]; };
            ld(tok0);
            for (int sb = 0; sb < nsb; ++sb) {
                { LAS float* base = wl + (lane >> 3) * SCAN_STEP + (lane & 7) * 8; float f[8];
                  *(LAS f32x4*)(base) = (f32x4){bf_lo(rq.x), bf_lo(rq.y), bf_lo(rq.z), bf_lo(rq.w)}; *(LAS f32x4*)(base + 4) = (f32x4){bf_lo(ru.x), bf_lo(ru.y), bf_lo(ru.z), bf_lo(ru.w)};
                  *(LAS f32x4*)(base + 256) = (f32x4){bf_hi(rq.x), bf_hi(rq.y), bf_hi(rq.z), bf_hi(rq.w)}; *(LAS f32x4*)(base + 260) = (f32x4){bf_hi(ru.x), bf_hi(ru.y), bf_hi(ru.z), bf_hi(ru.w)};
                  unpack8(rv, f); *(LAS f32x4*)(base + 320) = (f32x4){f[0], f[1], f[2], f[3]}; *(LAS f32x4*)(base + 324) = (f32x4){f[4], f[5], f[6], f[7]};
                  unpack8(rg, f); *(LAS f32x4*)(base + 384) = (f32x4){f[0], f[1], f[2], f[3]}; *(LAS f32x4*)(base + 388) = (f32x4){f[4], f[5], f[6], f[7]};
                  if (lane < 8) wl[lane * SCAN_STEP + 448] = rb; }
                wave_sync();
                if (sb + 1 < nsb) ld(tok0 + 8 * (sb + 1));
#pragma unroll 1
                for (int s = 0; s < 8; ++s) { const LAS float* st = wl + s * SCAN_STEP; const LAS f32x4* Q4 = (const LAS f32x4*)st;
                    float o0 = 0.f, o1 = 0.f, o2 = 0.f, o3 = 0.f;
#pragma unroll
                    for (int q = 0; q < 16; ++q) { const f32x4 qv = Q4[q]; o0 = fmaf(S[4 * q], qv[0], o0); o1 = fmaf(S[4 * q + 1], qv[1], o1); o2 = fmaf(S[4 * q + 2], qv[2], o2); o3 = fmaf(S[4 * q + 3], qv[3], o3); }
                    const float o = ((o0 + o1) + (o2 + o3)) + st[256 + lane];
                    scan_c_finish(o, st, lw, lb, lane, OC + (size_t)(tok0 + 8 * sb + s) * 4096 + h * 64 + lane); }
                wave_sync();
            }
        }
    }
}

__device__ __forceinline__ unsigned okey(float f) { const unsigned u = __float_as_uint(f); return (u & 0x80000000u) ? ~u : (u | 0x80000000u); }
constexpr int IDX_HIST = 131072, IDX_MISC = LDS_MISC + 256, IDX_LIST = LDS_MISC + 1024;
template <int NQ, bool SAMPLE>
__device__ __forceinline__ void indexer_task(const Ctx& X, int task) {
    constexpr int SCLD = SAMPLE ? 2064 : 8192, WPQ = 8 / NQ, TPQ = 64 * WPQ;
    int lane = X.lane; asm volatile("" : "+v"(lane));
    const int wave = X.wave, tid = wave * 64 + lane, fr = lane & 15, fq = lane >> 4;
    const bf16_t* Z = X.W<bf16_t>(WS_Z); const bf16_t* KIB = X.W<bf16_t>(WS_KIB); const float* WI = X.W<float>(WS_WI);
    LAS float* sc = (LAS float*)X.lds;
    const int tokbase = SAMPLE ? SEQ + task * 8 : task * 4;
#ifdef STAMP_BUILD
    unsigned long long* stw = X.W<unsigned long long>(WS_CTL) + 16384 + 40 + (SAMPLE ? 2 : 0); const bool stamper = (X.bid == 0 && tid == 0);
    const unsigned long long ts0 = wall_clock64();
#endif
    if constexpr (!SAMPLE) {
        const int c32 = lane & 31, hf = lane >> 5;
        bf16x8 Aq[2][4]; float wv[2][16];
#pragma unroll
        for (int p = 0; p < 2; ++p) {
            const int qrow = tokbase + 2 * p + ((c32 >> 2) & 1), head = (c32 & 3) + 4 * (c32 >> 3);
            const bf16_t* zq = Z + (size_t)qrow * ZLD + C_QI + head * 64 + hf * 8;
#pragma unroll
            for (int ks = 0; ks < 4; ++ks) Aq[p][ks] = *(const bf16x8*)(zq + 16 * ks);
            const float* wp = WI + (size_t)(tokbase + 2 * p + hf) * 16;
#pragma unroll
            for (int i4 = 0; i4 < 4; ++i4) { const f32x4 v = *(const f32x4*)(wp + 4 * i4); wv[p][4 * i4] = v[0]; wv[p][4 * i4 + 1] = v[1]; wv[p][4 * i4 + 2] = v[2]; wv[p][4 * i4 + 3] = v[3]; }
        }
        const int nkt = (tokbase + 4 + 31) >> 5;
        float smx[2] = {-__builtin_inff(), -__builtin_inff()}, smn[2] = {__builtin_inff(), __builtin_inff()};
        const unsigned char* kbase = X.ws + WS_KIB; const unsigned klane = (unsigned)(lane * 16);
        constexpr int KU = 8;
        for (int kt0 = wave * KU; kt0 < nkt; kt0 += 8 * KU) {
            bf16x8 kb[KU][4];
#pragma unroll
            for (int u = 0; u < KU; ++u) { const int kt = kt0 + u; const unsigned char* kr = kbase + (size_t)(kt < nkt ? kt : nkt - 1) * 4096;
#pragma unroll
                for (int ks = 0; ks < 4; ++ks) kb[u][ks] = *(const bf16x8*)(kr + (klane + 1024u * ks)); }
#pragma unroll
            for (int u = 0; u < KU; ++u) {
                const int kt = kt0 + u, key = kt * 32 + c32;
#pragma unroll
                for (int p = 0; p < 2; ++p) {
                    f32x16 acc;
#pragma unroll
                    for (int i = 0; i < 16; ++i) acc[i] = 0.f;
#pragma unroll
                    for (int ks = 0; ks < 4; ++ks) acc = __builtin_amdgcn_mfma_f32_32x32x16_bf16(Aq[p][ks], kb[u][ks], acc, 0, 0, 0);
                    float s0 = 0.f, s1 = 0.f;
#pragma unroll
                    for (int i = 0; i < 16; i += 2) { s0 = fmaf(wv[p][i], fmaxf(acc[i], 0.f), s0); s1 = fmaf(wv[p][i + 1], fmaxf(acc[i + 1], 0.f), s1); }
                    const float sv = s0 + s1;
                    if (kt * 32 + 31 <= tokbase) { sc[(2 * p + hf) * SCLD + key] = sv; smx[p] = fmaxf(smx[p], sv); smn[p] = fminf(smn[p], sv); }
                    else if (kt < nkt && key <= tokbase + 2 * p + hf) { sc[(2 * p + hf) * SCLD + key] = sv; smx[p] = fmaxf(smx[p], sv); smn[p] = fminf(smn[p], sv); }
                }
            }
        }
        LAS unsigned* mm = (LAS unsigned*)(X.lds + IDX_MISC);
#pragma unroll
        for (int p = 0; p < 2; ++p) { __hip_atomic_fetch_max(&mm[2 * (2 * p + hf)], okey(smx[p]), __ATOMIC_RELAXED, __HIP_MEMORY_SCOPE_WORKGROUP);
                                      __hip_atomic_fetch_min(&mm[2 * (2 * p + hf) + 1], okey(smn[p]), __ATOMIC_RELAXED, __HIP_MEMORY_SCOPE_WORKGROUP); }
    } else {
    bf16x8 Af[NQ][2]; float wq[NQ];
#pragma unroll
    for (int qq = 0; qq < NQ; ++qq) { const bf16_t* zq = Z + (size_t)(tokbase + qq) * ZLD + C_QI + fr * 64 + fq * 8;
        Af[qq][0] = *(const bf16x8*)zq; Af[qq][1] = *(const bf16x8*)(zq + 32);
        wq[qq] = WI[(size_t)(tokbase + qq) * 16 + fr]; }
    const int nkeys = SAMPLE ? PAST + 8 : tokbase + 4, nkt = (nkeys + 15) >> 4;
    constexpr int KU = SAMPLE ? 4 : 8;
    for (int kt0 = wave * KU; kt0 < nkt; kt0 += 8 * KU) {
        bf16x8 b0[KU], b1[KU];
#pragma unroll
        for (int u = 0; u < KU; ++u) {
            const int kt = kt0 + u, key = (kt < nkt ? kt : nkt - 1) * 16 + fr;
            if (!SAMPLE || key >= PAST) {
                const int krow = SAMPLE ? SEQ + task * 8 + (key - PAST) : key;
                if (!SAMPLE || key < PAST + 8) { const unsigned char* kr = (const unsigned char*)KIB + (size_t)(krow >> 5) * 4096 + (fq >> 1) * 1024 + ((krow & 31) + 32 * (fq & 1)) * 16;
                    b0[u] = *(const bf16x8*)kr; b1[u] = *(const bf16x8*)(kr + 2048); }
                else { b0[u] = (bf16x8){0, 0, 0, 0, 0, 0, 0, 0}; b1[u] = b0[u]; }
            } else {
                const int page = ((const int*)X.in[I_PT])[task * NPAGES + (key >> 7)];
                const float* kr = X.in[I_CKI] + ((size_t)page * PAGE + (key & 127)) * 64 + fq * 8;
                const f32x4 x0 = *(const f32x4*)kr, x1 = *(const f32x4*)(kr + 4), y0 = *(const f32x4*)(kr + 32), y1 = *(const f32x4*)(kr + 36);
                u32x4 w0, w1; w0.x = cvt_pk_bf16(x0[0], x0[1]); w0.y = cvt_pk_bf16(x0[2], x0[3]); w0.z = cvt_pk_bf16(x1[0], x1[1]); w0.w = cvt_pk_bf16(x1[2], x1[3]);
                w1.x = cvt_pk_bf16(y0[0], y0[1]); w1.y = cvt_pk_bf16(y0[2], y0[3]); w1.z = cvt_pk_bf16(y1[0], y1[1]); w1.w = cvt_pk_bf16(y1[2], y1[3]);
                b0[u] = __builtin_bit_cast(bf16x8, w0); b1[u] = __builtin_bit_cast(bf16x8, w1);
            }
        }
#pragma unroll
        for (int u = 0; u < KU; ++u) {
            const int kt = kt0 + u;
#pragma unroll
            for (int qq = 0; qq < NQ; ++qq) {
                f32x4 acc = {0.f, 0.f, 0.f, 0.f};
                acc = __builtin_amdgcn_mfma_f32_16x16x32_bf16(b0[u], Af[qq][0], acc, 0, 0, 0);
                acc = __builtin_amdgcn_mfma_f32_16x16x32_bf16(b1[u], Af[qq][1], acc, 0, 0, 0);
                const float s0 = row16_sum(wq[qq] * fmaxf(acc[0], 0.f)), s1 = row16_sum(wq[qq] * fmaxf(acc[1], 0.f)), s2 = row16_sum(wq[qq] * fmaxf(acc[2], 0.f)), s3 = row16_sum(wq[qq] * fmaxf(acc[3], 0.f));
                const float sv = fr == 0 ? s0 : (fr == 1 ? s1 : (fr == 2 ? s2 : s3));
                const int key = kt * 16 + 4 * fq + fr, lim = SAMPLE ? PAST + qq : tokbase + qq;
                if (fr < 4 && kt < nkt && key <= lim) sc[qq * SCLD + key] = sv;
            }
        }
    }
    }
    __syncthreads();
#ifdef STAMP_BUILD
    const unsigned long long ts1 = wall_clock64();
#endif
    {
        constexpr int CAPC = SAMPLE ? 384 : 768, NCOPY = 16 / NQ, WPQ = SAMPLE ? 1 : 2;
        const int qq = SAMPLE ? wave : (wave & (NQ - 1)), role = SAMPLE ? 0 : (wave / NQ);
        const int n = SAMPLE ? PAST + 1 + qq : tokbase + qq + 1, nsel = n < 256 ? n : 256;
        int* idxo = X.W<int>(WS_IDX) + (size_t)(tokbase + qq) * 256;
        const LAS float* scq = sc + qq * SCLD;
        LAS unsigned* hist = (LAS unsigned*)(X.lds + IDX_HIST) + qq * (NCOPY * 256);
        LAS unsigned short* list = (LAS unsigned short*)(X.lds + IDX_LIST) + qq * CAPC;
        auto sync = [&]() { if constexpr (SAMPLE) wave_sync(); else __syncthreads(); };
        if (role == 0 && lane == 0) X.W<int>(WS_NSEL)[tokbase + qq] = nsel;
        const int n4 = n >> 2, ntail = n & 3, gmid = (WPQ == 2) ? (n4 >> 1) : n4;
        const int glo = role == 0 ? 0 : gmid, ghi = (role == WPQ - 1) ? n4 : gmid; const bool dotail = (role == WPQ - 1) && ntail;
        auto sweep = [&](auto&& f) {
#pragma unroll 2
            for (int g0 = glo; g0 < ghi; g0 += 64) { const int g = g0 + lane; const bool ok = g < ghi; const f32x4 v = *(const LAS f32x4*)(scq + 4 * (ok ? g : 0));
#pragma unroll
                for (int e = 0; e < 4; ++e) f(v[e], 4 * g + e, ok); }
            if (dotail) { const bool ok = lane < ntail; const int idx = 4 * n4 + (ok ? lane : 0); f(scq[idx], idx, ok); } };
        float hif = -__builtin_inff(), lof = __builtin_inff();
        if (n > 256) {
            if constexpr (SAMPLE) {
                sweep([&](float v, int, bool ok) { if (ok) { hif = fmaxf(hif, v); lof = fminf(lof, v); } });
#pragma unroll
                for (int d = 1; d < 64; d <<= 1) { hif = fmaxf(hif, __shfl_xor(hif, d)); lof = fminf(lof, __shfl_xor(lof, d)); }
            } else {
                const LAS unsigned* mm = (const LAS unsigned*)(X.lds + IDX_MISC) + 2 * qq;
                const unsigned uh = mm[0], ul = mm[1];
                hif = __uint_as_float((uh & 0x80000000u) ? (uh ^ 0x80000000u) : ~uh); lof = __uint_as_float((ul & 0x80000000u) ? (ul ^ 0x80000000u) : ~ul);
            }
        }
        const int mode = n <= 256 ? 0 : (hif == lof ? 1 : 2);
        if (mode < 2 && role == 0) { for (int i = lane; i < nsel; i += 64) idxo[i] = i; }
        const float scale = 256.f / (hif - lof);
        auto lbin = [&](float v) { const unsigned b = (unsigned)((v - lof) * scale); return b > 255u ? 255u : b; };
        const int rot = lane & (NCOPY - 1); LAS unsigned* hme = hist + rot * 256; const unsigned radd = 16u * rot;
        auto zero_hist = [&]() { for (int i = lane; i < NCOPY * 64; i += 64) *(LAS u32x4*)(hist + 4 * i) = (u32x4){0u, 0u, 0u, 0u}; };
        auto find_bin = [&](unsigned kneed, unsigned& bin, unsigned& above, unsigned& own) {
            unsigned c0 = 0, c1 = 0, c2 = 0, c3 = 0;
#pragma unroll
            for (int cp = 0; cp < NCOPY; ++cp) { const LAS unsigned* h = hist + cp * 256; const int r = 16 * cp;
                c0 += h[(255 - 4 * lane + r) & 255]; c1 += h[(254 - 4 * lane + r) & 255]; c2 += h[(253 - 4 * lane + r) & 255]; c3 += h[(252 - 4 * lane + r) & 255]; }
            const unsigned tot = c0 + c1 + c2 + c3; unsigned incl = tot;
#pragma unroll
            for (int d = 1; d < 64; d <<= 1) { const unsigned v = __shfl_up(incl, d); if (lane >= d) incl += v; }
            const unsigned long long m = __ballot(incl >= kneed);
            const int L = m ? (__ffsll((long long)m) - 1) : 63;
            unsigned ab = incl - tot, cs; int bn;
            if (ab + c0 >= kneed) { bn = 255 - 4 * lane; cs = c0; } else { ab += c0;
            if (ab + c1 >= kneed) { bn = 254 - 4 * lane; cs = c1; } else { ab += c1;
            if (ab + c2 >= kneed) { bn = 253 - 4 * lane; cs = c2; } else { ab += c2; bn = 252 - 4 * lane; cs = c3; } } }
            bin = (unsigned)__shfl(bn, L); above = __shfl(ab, L); own = __shfl(cs, L); };
        if (mode == 2 && role == 0) zero_hist();
        sync();
        if (mode == 2) sweep([&](float v, int, bool ok) { if (ok) __hip_atomic_fetch_add(&hme[(lbin(v) + radd) & 255u], 1u, __ATOMIC_RELAXED, __HIP_MEMORY_SCOPE_WORKGROUP); });
        sync();
        unsigned B = 0u, above = 0u, cB = 0u, kneed = 256u;
        if (mode == 2) {
            find_bin(kneed, B, above, cB); kneed -= above;
            const bool uselist = cB <= (unsigned)CAPC;
            unsigned scnt = 0u, ccnt = 0u;
            sweep([&](float v, int idx, bool ok) { const unsigned dg = lbin(v); const bool sel = ok && dg > B, cand = ok && dg == B;
                const unsigned long long m1 = __ballot(sel), m2 = __ballot(cand);
                if (sel) { const unsigned k = scnt + __builtin_amdgcn_mbcnt_hi((unsigned)(m1 >> 32), __builtin_amdgcn_mbcnt_lo((unsigned)m1, 0u)); idxo[role == 0 ? k : above - 1u - k] = idx; }
                if (cand && uselist) { const unsigned k = ccnt + __builtin_amdgcn_mbcnt_hi((unsigned)(m2 >> 32), __builtin_amdgcn_mbcnt_lo((unsigned)m2, 0u)); list[role == 0 ? k : cB - 1u - k] = (unsigned short)idx; }
                scnt += (unsigned)__popcll(m1); ccnt += (unsigned)__popcll(m2); });
        }
        sync();
        if (mode == 2 && role == 0) {
            unsigned base = above;
            const bool uselist = cB <= (unsigned)CAPC; const int m = uselist ? (int)cB : n;
            auto csweep = [&](auto&& f) {
                for (int j0 = 0; j0 < m; j0 += 64) { const int j = j0 + lane; const bool in = j < m; const int idx = uselist ? (int)list[in ? j : 0] : (in ? j : 0);
                    const float v = scq[idx]; f(okey(v), idx, in && (uselist || lbin(v) == B)); } };
            unsigned hi = 0u, lo = 0xFFFFFFFFu;
            csweep([&](unsigned u, int, bool ok) { if (ok) { hi = u > hi ? u : hi; lo = u < lo ? u : lo; } });
#pragma unroll
            for (int d = 1; d < 64; d <<= 1) { const unsigned x = __shfl_xor(hi, d), y = __shfl_xor(lo, d); hi = x > hi ? x : hi; lo = y < lo ? y : lo; }
            hi = __builtin_amdgcn_readfirstlane(hi); lo = __builtin_amdgcn_readfirstlane(lo);
            int top = (hi == lo) ? 0 : 32 - __clz(hi ^ lo);
            unsigned prefix = top >= 32 ? 0u : ((hi >> top) << top);
            while (top > 0) {
                const int s2 = top > 8 ? top - 8 : 0; const unsigned dmask = (1u << (top - s2)) - 1u;
                zero_hist(); wave_sync();
                csweep([&](unsigned u, int, bool ok) { if (ok && (top >= 32 || (u >> top) == (prefix >> top))) __hip_atomic_fetch_add(&hme[(((u >> s2) & dmask) + radd) & 255u], 1u, __ATOMIC_RELAXED, __HIP_MEMORY_SCOPE_WORKGROUP); });
                wave_sync();
                unsigned B2, ab2, own2; find_bin(kneed, B2, ab2, own2); kneed -= ab2; prefix |= B2 << s2; top = s2;
            }
            unsigned ties = 0u;
            csweep([&](unsigned u, int idx, bool ok) { const bool sel = ok && u > prefix, tie = ok && u == prefix;
                const unsigned long long m1 = __ballot(sel), m2 = __ballot(tie);
                if (sel) idxo[base + __builtin_amdgcn_mbcnt_hi((unsigned)(m1 >> 32), __builtin_amdgcn_mbcnt_lo((unsigned)m1, 0u))] = idx;
                base += (unsigned)__popcll(m1);
                if (tie) { const unsigned e = ties + __builtin_amdgcn_mbcnt_hi((unsigned)(m2 >> 32), __builtin_amdgcn_mbcnt_lo((unsigned)m2, 0u)); if (e < kneed) idxo[255u - e] = idx; }
                ties += (unsigned)__popcll(m2); });
        }
    }
    __syncthreads();
#ifdef STAMP_BUILD
    if (stamper) { const unsigned long long ts2 = wall_clock64(); stw[0] += ts1 - ts0; stw[1] += ts2 - ts1; }
#endif
}
constexpr int CW_IDXQ = 20480;
__device__ __forceinline__ void phase_index(const Ctx& X) {
    const int npr = SEQ / 4, ntask = DEC_B + npr;
    unsigned* head = X.W<unsigned>(WS_CTL) + CW_IDXQ;
    LAS unsigned* slot = (LAS unsigned*)(X.lds + LDS_MISC + 512);
    for (;;) {
        if (X.tid == 0) *slot = __hip_atomic_fetch_add(head, 1u, __ATOMIC_RELAXED, __HIP_MEMORY_SCOPE_AGENT);
        __syncthreads();
        const int k = (int)*slot;
        if (X.tid < 8) ((LAS unsigned*)(X.lds + IDX_MISC))[X.tid] = (X.tid & 1) ? 0xFFFFFFFFu : 0u;
        __syncthreads();
        if (k >= ntask) break;
        if (k < DEC_B) indexer_task<8, true>(X, k); else indexer_task<4, false>(X, npr - 1 - (k - DEC_B));
    }
}

constexpr int ATT_WLDS = SCAN_WLDS;
static_assert(4096 + 4096 + 2048 <= SCAN_WLDS, "attention scratch must fit the per-wave scan region");
__device__ __forceinline__ void attn_task_smp(const Ctx& X, int t, int n) {
    constexpr int TG = 4, PU = 12;
    int lane = X.lane; asm volatile("" : "+v"(lane));
    const int fr = lane & 15, fq = lane >> 4;
    LAS float* lg = (LAS float*)(X.lds + X.wave * ATT_WLDS);
    LAS float* pT = lg + 1024;
    LAS int* lidx = (LAS int*)(pT + 1024);
    const bf16_t* QB = X.W<bf16_t>(WS_QB);
    const int ns = X.W<int>(WS_NSEL)[t];
    const int* idxg = X.W<int>(WS_IDX) + (size_t)t * 256;
    const int b = (t - SEQ) >> 3;
    const int* pt = (const int*)X.in[I_PT] + b * NPAGES;
#pragma unroll
    for (int i = 0; i < 4; ++i) { const int s = lane + 64 * i; int v = 0;
        if (s < ns) { const int pos = idxg[s]; v = pos >= PAST ? pos - PAST : -(pt[pos >> 7] * PAGE + (pos & 127) + 1); }
        lidx[s] = v; }
    const float* knew = X.out + O_KS + (size_t)b * 8 * 512 + n * 128; const float* vnew = X.out + O_VS + (size_t)b * 8 * 512 + n * 128;
    const float* kch = X.in[I_CK] + n * 128; const float* vch = X.in[I_CV] + n * 128;
    bf16x8 Aq[4];
#pragma unroll
    for (int ks = 0; ks < 4; ++ks) { if (fr < 4) Aq[ks] = *(const bf16x8*)(QB + (size_t)t * DM + (4 * n + fr) * 128 + ks * 32 + fq * 8); else Aq[ks] = (bf16x8){0, 0, 0, 0, 0, 0, 0, 0}; }
    wave_sync();
    const int ntile = (ns + 15) >> 4;
    for (int kt0 = 0; kt0 < ntile; kt0 += TG) {
        f32x4 kx[TG][4][2];
#pragma unroll
        for (int g = 0; g < TG; ++g) {
            const int s = (kt0 + g) * 16 + fr; const int row = (kt0 + g < ntile) ? lidx[s] : 0;
            const float* kr = (row >= 0 ? knew + (size_t)row * 512 : kch + (size_t)(-row - 1) * 512) + fq * 8;
#pragma unroll
            for (int ks = 0; ks < 4; ++ks) { kx[g][ks][0] = *(const f32x4*)(kr + ks * 32); kx[g][ks][1] = *(const f32x4*)(kr + ks * 32 + 4); }
        }
#pragma unroll
        for (int g = 0; g < TG; ++g) {
            f32x4 acc = {0.f, 0.f, 0.f, 0.f};
#pragma unroll
            for (int ks = 0; ks < 4; ++ks) { const f32x4 x0 = kx[g][ks][0], x1 = kx[g][ks][1];
                u32x4 w; w.x = cvt_pk_bf16(x0[0], x0[1]); w.y = cvt_pk_bf16(x0[2], x0[3]); w.z = cvt_pk_bf16(x1[0], x1[1]); w.w = cvt_pk_bf16(x1[2], x1[3]);
                acc = __builtin_amdgcn_mfma_f32_16x16x32_bf16(Aq[ks], __builtin_bit_cast(bf16x8, w), acc, 0, 0, 0); }
            if (fq == 0 && kt0 + g < ntile) { const int s = (kt0 + g) * 16 + fr;
#pragma unroll
                for (int j = 0; j < 4; ++j) lg[j * 256 + s] = acc[j]; }
        }
    }
    wave_sync();
    {
        float l[16], m = -1e30f;
#pragma unroll
        for (int i = 0; i < 16; ++i) { const int s = fr * 16 + i; l[i] = (s < ns) ? lg[fq * 256 + s] : -1e30f; m = fmaxf(m, l[i]); }
        m = row16_max(m);
        float sum = 0.f;
#pragma unroll
        for (int i = 0; i < 16; ++i) { const int s = fr * 16 + i; const float e = (s < ns) ? __expf(l[i] - m) : 0.f; l[i] = e; sum += e; }
        sum = row16_sum(sum); const float inv = 1.f / sum;
#pragma unroll
        for (int i = 0; i < 16; ++i) pT[(fr * 16 + i) * 4 + fq] = l[i] * inv;
    }
    wave_sync();
    float acc[4][8];
#pragma unroll
    for (int hh = 0; hh < 4; ++hh)
#pragma unroll
        for (int d = 0; d < 8; ++d) acc[hh][d] = 0.f;
    const int nit = (ns + 3) >> 2;
    for (int it0 = 0; it0 < nit; it0 += PU) {
        f32x4 vx[PU][2];
#pragma unroll
        for (int u = 0; u < PU; ++u) { const int s = (it0 + u) * 4 + fq; const int row = (it0 + u < nit) ? lidx[s] : 0;
            const float* vr = (row >= 0 ? vnew + (size_t)row * 512 : vch + (size_t)(-row - 1) * 512) + fr * 8; vx[u][0] = *(const f32x4*)vr; vx[u][1] = *(const f32x4*)(vr + 4); }
#pragma unroll
        for (int u = 0; u < PU; ++u) { const int s = (it0 + u) * 4 + fq;
            f32x4 p4 = {0.f, 0.f, 0.f, 0.f}; if (it0 + u < nit) p4 = *(const LAS f32x4*)(pT + s * 4);
#pragma unroll
            for (int hh = 0; hh < 4; ++hh) {
#pragma unroll
                for (int d = 0; d < 4; ++d) { acc[hh][d] = fmaf(p4[hh], vx[u][0][d], acc[hh][d]); acc[hh][4 + d] = fmaf(p4[hh], vx[u][1][d], acc[hh][4 + d]); } }
        }
    }
#pragma unroll
    for (int hh = 0; hh < 4; ++hh)
#pragma unroll
        for (int d = 0; d < 8; ++d) { float a = acc[hh][d]; a += __shfl_xor(a, 16); a += __shfl_xor(a, 32); acc[hh][d] = a; }
    if (fq == 0) { bf16_t* op = X.W<bf16_t>(WS_OCAT) + (size_t)t * 4096 + 2048 + (4 * n) * 128 + fr * 8;
#pragma unroll
        for (int hh = 0; hh < 4; ++hh) *(u32x4*)(op + hh * 128) = pack8(acc[hh]); }
    wave_sync();
}
struct AttnPre { int ns; int idx[4]; };
struct AttnCur { int t, ns; long Aq[4]; u32x4 Bk[8][2]; };
__device__ __forceinline__ void attn_prefetch(const Ctx& X, int t, AttnPre& P) {
    int lane = X.lane; asm volatile("" : "+v"(lane));
    P.ns = X.W<int>(WS_NSEL)[t]; const unsigned char* ib = X.ws + WS_IDX + (size_t)t * 1024;
#pragma unroll
    for (int i = 0; i < 4; ++i) P.idx[i] = *(const int*)(ib + (unsigned)(lane * 4 + 256 * i));
}
__device__ __forceinline__ void attn_stage(const Ctx& X, int t, int n, const AttnPre& P, LAS int* lidx, AttnCur& C) {
    int lane = X.lane; asm volatile("" : "+v"(lane));
    const int fr = lane & 15, fq = lane >> 4;
    C.t = t; C.ns = P.ns;
#pragma unroll
    for (int i = 0; i < 4; ++i) { const int s = lane + 64 * i; lidx[s] = (s < P.ns) ? P.idx[i] : 0; }
    const unsigned char* Q8 = X.W<unsigned char>(WS_Q8) + (size_t)t * DM + (4 * n) * 128; const unsigned char* K8 = X.W<unsigned char>(WS_K8) + (size_t)n * (SEQ * 128);
#pragma unroll
    for (int ks = 0; ks < 4; ++ks) C.Aq[ks] = (fr < 4) ? *(const long*)(Q8 + (unsigned)(fr * 128 + ks * 32 + fq * 8)) : 0L;
    wave_sync();
#pragma unroll
    for (int g = 0; g < 8; ++g) { const unsigned ko = (unsigned)(lidx[g * 16 + fr] * 128 + fq * 16); C.Bk[g][0] = *(const u32x4*)(K8 + ko); C.Bk[g][1] = *(const u32x4*)(K8 + (ko + 64u)); }
}
__device__ __forceinline__ void attn_run8(const Ctx& X, int n, AttnCur& C, LAS int* lidx, int tnext, const AttnPre& P, LAS int* lidxn, AttnCur& Cn) {
    constexpr int PU = 8;
    int lane = X.lane; asm volatile("" : "+v"(lane));
    const int fr = lane & 15, fq = lane >> 4;
    LAS float* lg = (LAS float*)(X.lds + X.wave * ATT_WLDS);
    LAS float* pT = lg + 1024;
    const unsigned char* K8 = X.W<unsigned char>(WS_K8) + (size_t)n * (SEQ * 128); const unsigned char* V8 = X.W<unsigned char>(WS_V8) + (size_t)n * (SEQ * 128);
    const int t = C.t, ns = C.ns;
    u32x4 Bk1[8][2];
#pragma unroll
    for (int g = 0; g < 8; ++g) { const unsigned ko = (unsigned)(lidx[128 + g * 16 + fr] * 128 + fq * 16); Bk1[g][0] = *(const u32x4*)(K8 + ko); Bk1[g][1] = *(const u32x4*)(K8 + (ko + 64u)); }
    auto qk = [&](const u32x4 (&Bk)[8][2], int g0) {
#pragma unroll
        for (int g = 0; g < 8; ++g) {
            f32x4 acc = {0.f, 0.f, 0.f, 0.f};
            const long b0 = (long)(((unsigned long long)Bk[g][0].y << 32) | Bk[g][0].x), b1 = (long)(((unsigned long long)Bk[g][0].w << 32) | Bk[g][0].z),
                       b2 = (long)(((unsigned long long)Bk[g][1].y << 32) | Bk[g][1].x), b3 = (long)(((unsigned long long)Bk[g][1].w << 32) | Bk[g][1].z);
            acc = __builtin_amdgcn_mfma_f32_16x16x32_fp8_fp8(C.Aq[0], b0, acc, 0, 0, 0); acc = __builtin_amdgcn_mfma_f32_16x16x32_fp8_fp8(C.Aq[1], b1, acc, 0, 0, 0);
            acc = __builtin_amdgcn_mfma_f32_16x16x32_fp8_fp8(C.Aq[2], b2, acc, 0, 0, 0); acc = __builtin_amdgcn_mfma_f32_16x16x32_fp8_fp8(C.Aq[3], b3, acc, 0, 0, 0);
            if (fq == 0) { const int s = (g0 + g) * 16 + fr;
#pragma unroll
                for (int j = 0; j < 4; ++j) lg[j * 256 + s] = acc[j] * 0.08838834764831845f; }
        } };
    qk(C.Bk, 0);
    qk(Bk1, 8);
    u32x2 r0[PU], r1[PU], r2[PU];
    auto vload = [&](u32x2 (&v)[PU], int it0) {
#pragma unroll
        for (int u = 0; u < PU; ++u) v[u] = *(const u32x2*)(V8 + (unsigned)(lidx[(it0 + u) * 4 + fq] * 128 + fr * 8)); };
    vload(r0, 0); vload(r1, PU);
    wave_sync();
    {
        float l[16], m = -1e30f;
#pragma unroll
        for (int i = 0; i < 16; ++i) { const int s = fr * 16 + i; l[i] = (s < ns) ? lg[fq * 256 + s] : -1e30f; m = fmaxf(m, l[i]); }
        m = row16_max(m);
        float sum = 0.f;
#pragma unroll
        for (int i = 0; i < 16; ++i) { const int s = fr * 16 + i; const float e = (s < ns) ? __expf(l[i] - m) : 0.f; l[i] = e; sum += e; }
        sum = row16_sum(sum); const float inv = 1.f / sum;
#pragma unroll
        for (int i = 0; i < 16; ++i) pT[(fr * 16 + i) * 4 + fq] = l[i] * inv;
    }
    wave_sync();
    attn_stage(X, tnext >= 0 ? tnext : t, n, P, lidxn, Cn);
    float acc[4][8];
#pragma unroll
    for (int hh = 0; hh < 4; ++hh)
#pragma unroll
        for (int d = 0; d < 8; ++d) acc[hh][d] = 0.f;
    auto vfma = [&](const u32x2 (&vr)[PU], int it0) {
        f32x4 pc = *(const LAS f32x4*)(pT + (it0 * 4 + fq) * 4);
#pragma unroll
        for (int u = 0; u < PU; ++u) {
            u32x2 w = vr[u];
            asm volatile("" : "+v"(w.x), "+v"(acc[0][0]), "+v"(acc[0][1]), "+v"(acc[0][2]), "+v"(acc[0][3]), "+v"(acc[0][4]), "+v"(acc[0][5]), "+v"(acc[0][6]), "+v"(acc[0][7]),
                              "+v"(acc[1][0]), "+v"(acc[1][1]), "+v"(acc[1][2]), "+v"(acc[1][3]), "+v"(acc[1][4]), "+v"(acc[1][5]), "+v"(acc[1][6]), "+v"(acc[1][7]) :: "memory");
            asm volatile("" : "+v"(w.y), "+v"(acc[2][0]), "+v"(acc[2][1]), "+v"(acc[2][2]), "+v"(acc[2][3]), "+v"(acc[2][4]), "+v"(acc[2][5]), "+v"(acc[2][6]), "+v"(acc[2][7]),
                              "+v"(acc[3][0]), "+v"(acc[3][1]), "+v"(acc[3][2]), "+v"(acc[3][3]), "+v"(acc[3][4]), "+v"(acc[3][5]), "+v"(acc[3][6]), "+v"(acc[3][7]));
            f32x4 pn = pc; if (u + 1 < PU) pn = *(const LAS f32x4*)(pT + ((it0 + u + 1) * 4 + fq) * 4);
            float v[8]; unpack8_fp8(w, v);
#pragma unroll
            for (int hh = 0; hh < 4; ++hh)
#pragma unroll
                for (int d = 0; d < 8; ++d) acc[hh][d] = fmaf(pc[hh], v[d], acc[hh][d]);
            pc = pn;
        } };
    vload(r2, 2 * PU); vfma(r0, 0);
    vload(r0, 3 * PU); vfma(r1, PU);
    vload(r1, 4 * PU); vfma(r2, 2 * PU);
    vload(r2, 5 * PU); vfma(r0, 3 * PU);
    vload(r0, 6 * PU); vfma(r1, 4 * PU);
    vload(r1, 7 * PU); vfma(r2, 5 * PU);
    vfma(r0, 6 * PU); vfma(r1, 7 * PU);
#pragma unroll
    for (int hh = 0; hh < 4; ++hh)
#pragma unroll
        for (int d = 0; d < 8; ++d) { float a = acc[hh][d]; a += __shfl_xor(a, 16); a += __shfl_xor(a, 32); acc[hh][d] = a; }
    if (fq == 0) { bf16_t* op = X.W<bf16_t>(WS_OCAT) + (size_t)t * 4096 + 2048 + (4 * n) * 128 + fr * 8;
#pragma unroll
        for (int hh = 0; hh < 4; ++hh) *(u32x4*)(op + hh * 128) = pack8(acc[hh]); }
}
__device__ __forceinline__ void attn_samples(const Ctx& X) {
#pragma unroll 1
    for (int n0 = 0; n0 < 4; ++n0) {
        const int n = (X.bid + n0) & 3;
        unsigned* head = X.W<unsigned>(WS_CTL) + CW_IDXQ + 64 * (1 + n) + 32;
        for (;;) { unsigned k = 0; if (X.lane == 0) k = __hip_atomic_fetch_add(head, 1u, __ATOMIC_RELAXED, __HIP_MEMORY_SCOPE_AGENT);
            k = (unsigned)__builtin_amdgcn_readfirstlane((int)k);
            if (k >= (unsigned)(NTOK - SEQ)) break;
            attn_task_smp(X, SEQ + (int)k, n); }
    }
}
__device__ __forceinline__ void attn_prompts(const Ctx& X) {
    LAS int* lbuf = (LAS int*)(X.lds + X.wave * ATT_WLDS + 8192);
#pragma unroll 1
    for (int n0 = 0; n0 < 4; ++n0) {
        const int n = (X.bid + n0) & 3;
        unsigned* head = X.W<unsigned>(WS_CTL) + CW_IDXQ + 64 * (1 + n);
        auto pop = [&]() { unsigned k = 0; if (X.lane == 0) k = __hip_atomic_fetch_add(head, 1u, __ATOMIC_RELAXED, __HIP_MEMORY_SCOPE_AGENT); return k; };
        const unsigned k = (unsigned)__builtin_amdgcn_readfirstlane((int)pop());
        if (k >= (unsigned)SEQ) continue;
        AttnPre P; AttnCur C;
        attn_prefetch(X, (int)k, P);
        unsigned knv = pop();
        int b = 0;
        wave_sync();
        attn_stage(X, (int)k, n, P, lbuf, C);
#pragma unroll 1
        for (;;) {
            const unsigned kn = (unsigned)__builtin_amdgcn_readfirstlane((int)knv);
            const int tnext = kn < (unsigned)SEQ ? (int)kn : -1;
            if (tnext >= 0) { attn_prefetch(X, tnext, P); knv = pop(); }
            AttnCur Cn;
            attn_run8(X, n, C, lbuf + b * 256, tnext, P, lbuf + (b ^ 1) * 256, Cn);
            if (tnext < 0) break;
            C = Cn; b ^= 1;
        }
        wave_sync();
    }
}
__device__ __forceinline__ void late_weight_convert(const Ctx& X) {
    int lane = X.lane; asm volatile("" : "+v"(lane));
    LAS unsigned short* tile = (LAS unsigned short*)(X.lds + X.wave * SCAN_WLDS);
    const int kr = lane >> 4, nq = lane & 15;
    constexpr int T0 = 1024, T1 = 2048, T2 = 3072, T3 = 3072 + (DM / 64) * (UPN / 64), T4 = T3 + (DFF / 64) * (DM / 64);
    const int nslot = X.G * 8, slot0 = X.bid * 8 + X.wave;
#pragma unroll 1
    for (int ti = slot0; ti < T4; ti += nslot) {
        const float* src; bf16_t* dst; int N, ldd, loc;
        if (ti < T0) { src = X.in[I_WPA]; dst = X.W<bf16_t>(WS_WPA); N = DM; ldd = 4096; loc = ti; }
        else if (ti < T1) { src = X.in[I_WPB]; dst = X.W<bf16_t>(WS_WPA) + 2048; N = DM; ldd = 4096; loc = ti - T0; }
        else if (ti < T2) { src = X.in[I_WOUT]; dst = X.W<bf16_t>(WS_WOUT); N = DM; ldd = DM; loc = ti - T1; }
        else if (ti < T3) { src = X.in[I_WUP]; dst = X.W<bf16_t>(WS_WUP); N = UPN; ldd = DM; loc = ti - T2; }
        else { src = X.in[I_WDN]; dst = X.W<bf16_t>(WS_WDN); N = DM; ldd = DFF; loc = ti - T3; }
        const int nnt = N / 64, kt = loc / nnt, nt = loc - kt * nnt;
        f32x4 v[16];
        const float* sp = src + (size_t)(kt * 64 + kr) * N + nt * 64 + 4 * nq;
#pragma unroll
        for (int j = 0; j < 16; ++j) v[j] = __builtin_nontemporal_load((const f32x4*)(sp + (size_t)(4 * j) * N));
#pragma unroll
        for (int j = 0; j < 16; ++j) { u32x2 w; w.x = cvt_pk_bf16(v[j][0], v[j][1]); w.y = cvt_pk_bf16(v[j][2], v[j][3]); *(LAS u32x2*)(tile + (kr + 4 * j) * 68 + 4 * nq) = w; }
        wave_sync();
        const int ks = lane & 7, nr = lane >> 3;
        bf16_t* dp = dst + (size_t)(nt * 64 + nr) * ldd + kt * 64 + 8 * ks;
#pragma unroll
        for (int h = 0; h < 8; ++h) { unsigned short e[8];
#pragma unroll
            for (int j = 0; j < 8; ++j) e[j] = tile[(8 * ks + j) * 68 + 8 * h + nr];
            u32x4 w; w.x = e[0] | ((unsigned)e[1] << 16); w.y = e[2] | ((unsigned)e[3] << 16); w.z = e[4] | ((unsigned)e[5] << 16); w.w = e[6] | ((unsigned)e[7] << 16);
            __builtin_nontemporal_store(w, (u32x4*)(dp + (size_t)(8 * h) * ldd)); }
        wave_sync();
    }
}
__device__ __forceinline__ void phase_c_attn(const Ctx& X) {
    const bool hb = X.wave >= 4;
#pragma unroll 1
    for (int stage = 0; stage < 4; ++stage) {
        const int what = hb ? (stage == 0 ? 2 : stage == 1 ? 3 : stage - 2) : (stage == 0 ? 3 : stage - 1);
        if (what == 0) phase_scan_c(X);
        else if (what == 1) attn_prompts(X);
        else if (what == 2) attn_samples(X);
        else if (what == 3) late_weight_convert(X);
    }
}

__device__ __forceinline__ void phase_conv_act(const Ctx& X) {
    const bf16_t* U = X.W<bf16_t>(WS_U); bf16_t* ACT = X.W<bf16_t>(WS_ACT);
    const float* cw = X.in[I_CW]; const float* cb = X.in[I_CB];
    constexpr int PER = DFF / 8, NIT = NTOK * PER;
    struct Raw { float u0[8], uv[8], m1[8], m2[8]; };
    auto ld = [&](int item, Raw& R) {
        const int t = item / PER, f8 = (item - t * PER) * 8;
        const bool smp = t >= SEQ; const int tt = smp ? t - SEQ : t; const int p = smp ? (tt & 7) : t; const int b = tt >> 3;
        const bf16_t* ur = U + (size_t)t * UPN;
        unpack8(*(const u32x4*)(ur + f8), R.u0); unpack8(*(const u32x4*)(ur + DFF + f8), R.uv);
        const float* cprev = X.in[I_SCV] + (size_t)b * 2 * DFF;
        if (p >= 1) unpack8(*(const u32x4*)(ur - UPN + f8), R.m1);
        else {
#pragma unroll
            for (int j = 0; j < 8; ++j) R.m1[j] = smp ? cprev[DFF + f8 + j] : 0.f; }
        if (p >= 2) unpack8(*(const u32x4*)(ur - 2 * UPN + f8), R.m2);
        else {
#pragma unroll
            for (int j = 0; j < 8; ++j) R.m2[j] = smp ? cprev[p * DFF + f8 + j] : 0.f; } };
    auto fin = [&](int item, const Raw& R) {
        const int t = item / PER, f8 = (item - t * PER) * 8;
        const bool smp = t >= SEQ; const int tt = smp ? t - SEQ : t; const int p = smp ? (tt & 7) : t; const int b = tt >> 3;
        float o[8];
#pragma unroll
        for (int j = 0; j < 8; ++j) { const float a = cb[f8 + j] + cw[f8 + j] * R.m2[j] + cw[DFF + f8 + j] * R.m1[j] + cw[2 * DFF + f8 + j] * R.u0[j];
            o[j] = a * sigmoidf_(a) * R.uv[j]; }
        *(u32x4*)(ACT + (size_t)t * DFF + f8) = pack8(o);
        float* co = nullptr;
        if (!smp && t >= SEQ - 2) co = X.out + O_CVP + (size_t)(t - (SEQ - 2)) * DFF + f8;
        if (smp && p >= 6) co = X.out + O_CVS + ((size_t)b * 2 + (p - 6)) * DFF + f8;
        if (co) { *(f32x4*)co = (f32x4){R.u0[0], R.u0[1], R.u0[2], R.u0[3]}; *(f32x4*)(co + 4) = (f32x4){R.u0[4], R.u0[5], R.u0[6], R.u0[7]}; } };
    const int stride = X.G * 512;
    for (int item = X.bid * 512 + X.tid; item < NIT; item += 2 * stride) {
        Raw ra, rb; const bool two = item + stride < NIT;
        ld(item, ra); if (two) ld(item + stride, rb);
        fin(item, ra); if (two) fin(item + stride, rb);
    }
}

enum { PH_CONVERT = 0, PH_ADA, PH_NORM1, PH_GEMM1, PH_PREP1, PH_LORA, PH_PREP2, PH_SCAN_A, PH_SCAN_B, PH_SCAN_C, PH_INDEX, PH_ATTN, PH_PROJ, PH_OUT, PH_NORM2, PH_UP, PH_CONVACT, PH_DOWN, NPH };
#ifndef MK_N_LAUNCHES
#define MK_N_LAUNCHES 1
#endif
constexpr int CW_BAR = 1024;
#ifndef USE_TAILS
#define USE_TAILS 0
#endif
constexpr int CW_TAIL = 8192;

template <class Epi, int S_PARTS>
__device__ __forceinline__ void gemm_with_tail(const Ctx& X, const pg8::Gemm g, const Epi& E, int gemm_id) {
    using namespace pg8;
    StaticOrder S; S.init(g.M, g.N, X.G, X.bid);
    const int R = S.nwg / X.G;
    const bool tails = USE_TAILS || gemm_id == 5;
    if (!tails || S.nwg == R * X.G) { S.split_tail(); gemm_phase<Epi, StaticOrder, true, true>(X.lds, g, S, E, X.wave); return; }
    S.limit = R * X.G;
    if (R > 0) gemm_phase<Epi, StaticOrder, true, true>(X.lds, g, S, E, X.wave);
    TailOrder T; T.init_tail(g.M, g.N, X.G, X.bid, S_PARTS, g.K / S_PARTS);
    Gemm gt = g; gt.K = g.K / S_PARTS;
    EpiTail<Epi> ET{E, X.W<float>(WS_SLAB), X.W<unsigned>(WS_CTL) + CW_TAIL + gemm_id * 1024, S_PARTS};
    gemm_phase<EpiTail<Epi>, TailOrder, true, true>(X.lds, gt, T, ET, X.wave);
}

struct Args { const float* in[36]; float* out; unsigned char* ws; int ph_lo, ph_hi; };
__device__ __forceinline__ void fresh(Ctx& X) { KTab t = X.in; asm volatile("" : "+s"(t)); X.in = t; X.lane = lane_id_fresh(); X.tid = X.wave * 64 + X.lane; }

__global__ void __launch_bounds__(512, 2) mega(Args a) {
    extern __shared__ __attribute__((aligned(16))) unsigned char lds_raw[];
    Ctx X;
    X.in = (KTab)__builtin_amdgcn_kernarg_segment_ptr();
    X.out = a.out; X.ws = a.ws; X.lds = (LAS unsigned char*)lds_raw;
    X.wave = __builtin_amdgcn_readfirstlane((int)threadIdx.x >> 6); X.lane = lane_id_fresh(); X.tid = X.wave * 64 + X.lane; X.G = gridDim.x; X.bid = blockIdx.x;
    const int lo = a.ph_lo, hi = a.ph_hi;
    const bool multi = (hi - lo) > 1;
    volatile LAS unsigned* MISC = (volatile LAS unsigned*)(X.lds + LDS_MISC);
    if (X.tid < 4) MISC[X.tid] = 0u;
    __syncthreads();
    XcdBarrier bar; bar.bar = X.W<unsigned>(WS_CTL) + CW_BAR; bar.x = 0; bar.st = MISC;
    if (multi) bar = xcd_barrier_post(X.W<unsigned>(WS_CTL) + CW_BAR, MISC);
#ifndef PHASE_MASK
#define PHASE_MASK 0xFFFFFFFFu
#endif
#define IN(k) (((PHASE_MASK >> (k)) & 1u) && (fresh(X), lo <= (k) && (k) < hi))
#ifdef STAMP_BUILD
#define SEAM(k) do { if ((k) + 1 < hi) xcd_barrier(bar); if (X.bid == 0 && threadIdx.x == 0) X.W<unsigned long long>(WS_CTL)[16384 + (k) + 1] = wall_clock64(); } while (0)
#else
#define SEAM(k) do { if ((k) + 1 < hi) xcd_barrier(bar); } while (0)
#endif
    using namespace pg8;
    bf16_t* const Zb = X.W<bf16_t>(WS_Z); float* const MOD = X.W<float>(WS_MOD);

#ifdef STAMP_BUILD
    if (X.bid == 0 && threadIdx.x == 0) X.W<unsigned long long>(WS_CTL)[16384] = wall_clock64();
#endif
    if (IN(PH_CONVERT)) { phase_convert(X); SEAM(PH_CONVERT); }
    if (IN(PH_NORM1)) { phase_norm_mod(X, X.in[I_XP], X.in[I_XS], X.in[I_N1G], 0, 2048, X.W<bf16_t>(WS_H)); SEAM(PH_NORM1); }
    if (IN(PH_GEMM1)) {
        Gemm g{X.W<bf16_t>(WS_H), X.W<bf16_t>(WS_WIN), NTOK, ZLD, DM, DM, DM};
        EpiBf16<0> E{Zb, ZLD, nullptr};
        gemm_with_tail<EpiBf16<0>, 8>(X, g, E, 0);
        SEAM(PH_GEMM1);
    }
    if (IN(PH_PREP1)) { phase_prep1(X); SEAM(PH_PREP1); }
    if (IN(PH_LORA)) {
        StaticOrder S; S.init(NTOK, DM, X.G, X.bid);
        { Gemm g{X.W<bf16_t>(WS_ADEC), X.W<bf16_t>(WS_WDEC), NTOK, DM, 256, 256, 256}; EpiBf16<1> E{X.W<bf16_t>(WS_LW), DM, X.in[I_W0]};
          gemm_phase<EpiBf16<1>, StaticOrder, true, true>(X.lds, g, S, E, X.wave); }
        S.init(NTOK, DM, X.G, (X.bid + X.G - 32) % X.G);
        { Gemm g{X.W<bf16_t>(WS_AAIN), X.W<bf16_t>(WS_WA), NTOK, DM, 256, 256, 256}; EpiBf16<2> E{X.W<bf16_t>(WS_AAO), DM, X.in[I_A0]};
          gemm_phase<EpiBf16<2>, StaticOrder, true, true>(X.lds, g, S, E, X.wave); }
        S.init(NTOK, DM, X.G, (X.bid + X.G - 64) % X.G);
        { Gemm g{X.W<bf16_t>(WS_AGIN), X.W<bf16_t>(WS_WG), NTOK, DM, 256, 256, 256}; EpiBf16<0> E{X.W<bf16_t>(WS_GG), DM, nullptr};
          gemm_phase<EpiBf16<0>, StaticOrder, true, true>(X.lds, g, S, E, X.wave); }
        SEAM(PH_LORA);
    }
    if (IN(PH_PREP2)) { phase_prep2(X); }
    if (IN(PH_SCAN_A)) { phase_scan_a(X); SEAM(PH_SCAN_A); }
    if (IN(PH_SCAN_B)) { phase_scan_b(X); __syncthreads(); phase_index(X); SEAM(PH_SCAN_B); }
    if (IN(PH_SCAN_C)) { phase_c_attn(X); SEAM(PH_SCAN_C); }
#ifdef STAMP_BUILD
#define STAMPK(k) do { if (X.bid == 0 && threadIdx.x == 0) X.W<unsigned long long>(WS_CTL)[16384 + (k) + 1] = wall_clock64(); } while (0)
#else
#define STAMPK(k) do { } while (0)
#endif
    if (IN(PH_INDEX)) { STAMPK(PH_INDEX); }
    if (IN(PH_ATTN)) { STAMPK(PH_ATTN); }
    if (IN(PH_PROJ)) {
        { Gemm g{X.W<bf16_t>(WS_OCAT), X.W<bf16_t>(WS_WPA), NTOK, DM, DM, 4096, 4096}; EpiProjA E{X.W<bf16_t>(WS_TMPA), Zb};
          gemm_with_tail<EpiProjA, 8>(X, g, E, 1); }
#if USE_TAILS
        xcd_barrier(bar);
#endif
        { Gemm g{X.W<bf16_t>(WS_OCAT) + 2048, X.W<bf16_t>(WS_WPA) + 2048, NTOK, DM, DM, 4096, 4096}; EpiProjB E{X.W<bf16_t>(WS_TMPA), Zb, X.W<bf16_t>(WS_MIX)};
          gemm_with_tail<EpiProjB, 8>(X, g, E, 2); }
        SEAM(PH_PROJ);
    }
    if (IN(PH_OUT)) {
        Gemm g{X.W<bf16_t>(WS_MIX), X.W<bf16_t>(WS_WOUT), NTOK, DM, DM, DM, DM};
        EpiResidual E{X.in[I_XP], X.in[I_XS], MOD, 4096, X.W<float>(WS_XM)};
        gemm_with_tail<EpiResidual, 8>(X, g, E, 3);
        SEAM(PH_OUT);
    }
    if (IN(PH_NORM2)) { phase_norm_mod(X, X.W<float>(WS_XM), X.W<float>(WS_XM) + (size_t)SEQ * DM, X.in[I_N2G], 6144, 8192, X.W<bf16_t>(WS_H)); SEAM(PH_NORM2); }
    if (IN(PH_UP)) {
        Gemm g{X.W<bf16_t>(WS_H), X.W<bf16_t>(WS_WUP), NTOK, UPN, DM, DM, DM};
        EpiBf16<0> E{X.W<bf16_t>(WS_U), UPN, nullptr};
        gemm_with_tail<EpiBf16<0>, 8>(X, g, E, 4);
        SEAM(PH_UP);
    }
    if (IN(PH_CONVACT)) { phase_conv_act(X); SEAM(PH_CONVACT); }
    if (IN(PH_DOWN)) {
        Gemm g{X.W<bf16_t>(WS_ACT), X.W<bf16_t>(WS_WDN), NTOK, DM, DFF, DFF, DFF};
        EpiResidual E{X.W<float>(WS_XM), X.W<float>(WS_XM) + (size_t)SEQ * DM, MOD, 10240, X.out + O_YP};
        gemm_with_tail<EpiResidual, 4>(X, g, E, 5);
#ifdef STAMP_BUILD
        xcd_barrier(bar);
        if (X.bid == 0 && threadIdx.x == 0) {
            const unsigned long long* st = X.W<unsigned long long>(WS_CTL) + 16384; const unsigned long long tend = wall_clock64();
            auto us = [&](int a_, int b_) { return (int)(((b_ == NPH ? tend : st[b_]) - st[a_]) / 100ull); };
#if STAMP_BUILD == 4
            const unsigned long long* sw = st + 40;
            const int cnt[7] = { (int)(sw[0] / 100ull), (int)(sw[1] / 100ull), (int)(sw[4] / 100ull), (int)(sw[5] / 100ull), (int)(sw[6] / 100ull), 0, 0 };
#elif STAMP_BUILD == 3
            const unsigned long long* sw = st + 40;
            const int cnt[7] = { (int)(sw[0] / 100ull), (int)(sw[1] / 100ull), (int)(sw[2] / 100ull), (int)(sw[3] / 100ull), us(10, 11), 0, 0 };
#elif STAMP_BUILD == 1
            const int cnt[7] = { us(0, 1), us(3, 4), us(7, 8), us(8, 9), us(9, 10), us(10, 11), us(11, 12) };
#else
            const int cnt[7] = { us(1, 3), us(4, 5), us(5, 6), us(6, 7), us(12, 14), us(14, 16), us(16, NPH) };
#endif
            const size_t off[7] = { O_YP, O_RWS, O_KP, O_VP, O_YS, O_CVS, O_SHS };
            for (int o = 0; o < 7; ++o) for (int i = 0; i < cnt[o] / 4; ++i) ((unsigned*)X.out)[off[o] + i] = 0xAAAAAAAAu;
        }
#endif
    }
#undef IN
#undef SEAM
}

extern "C" void kernel_launch(void* const* d_in, const int* in_sizes, int n_in, void* d_out, int out_size, void* d_ws, size_t ws_size, hipStream_t stream) {
    static int grid = 0;
    if (grid == 0) {
        if (n_in != 36 || (size_t)out_size != O_END || ws_size < WS_END) { fprintf(stderr, "kernel_launch: unexpected shapes: n_in %d out %d ws %zu (need %zu)\n", n_in, out_size, ws_size, (size_t)WS_END); grid = -1; return; }
        int dev = 0, cus = 0, per_cu = 0;
        if (hipGetDevice(&dev) != hipSuccess || hipDeviceGetAttribute(&cus, hipDeviceAttributeMultiprocessorCount, dev) != hipSuccess) { grid = -1; return; }
        if (hipFuncSetAttribute((const void*)mega, hipFuncAttributeMaxDynamicSharedMemorySize, LDS_BYTES) != hipSuccess) { fprintf(stderr, "kernel_launch: hipFuncSetAttribute failed\n"); grid = -1; return; }
        if (hipOccupancyMaxActiveBlocksPerMultiprocessor(&per_cu, (const void*)mega, 512, LDS_BYTES) != hipSuccess || per_cu < 1) fprintf(stderr, "kernel_launch: occupancy query says %d\n", per_cu);
        (void)hipGetLastError();
        grid = cus;
    }
    if (grid < 0) return;
#ifdef STAMP_BUILD
    (void)hipMemsetAsync((char*)d_ws + WS_CTL, 0, CTL_BYTES, stream);
#else
    static_assert((CW_IDXQ + 64 * 5 + 64) * 4 <= (128 << 10) && (CW_TAIL + 6 * 1024) * 4 <= (128 << 10), "control words must lie inside the reset range");
    (void)hipMemsetAsync((char*)d_ws + WS_CTL, 0, (size_t)128 << 10, stream);
#endif
    Args a{};
    for (int i = 0; i < 36; ++i) a.in[i] = (const float*)d_in[i];
    a.out = (float*)d_out; a.ws = (unsigned char*)d_ws;
    constexpr int NL = MK_N_LAUNCHES;
    for (int li = 0; li < NL; ++li) {
        a.ph_lo = (NL == 1) ? 0 : li; a.ph_hi = (NL == 1) ? NPH : li + 1;
        hipLaunchKernelGGL(mega, dim3(grid), dim3(512), LDS_BYTES, stream, a);
        const hipError_t le = hipPeekAtLastError();
        if (le != hipSuccess) { fprintf(stderr, "kernel_launch: launch %d failed: %s\n", li, hipGetErrorName(le)); break; }
    }
}
```
